# Optimizing an MI355X kernel written in HIP

```python
import jax, jax.numpy as jnp
from jax import lax
import numpy as np

D_MODEL = 4096
BATCH = 4
SEQ = 4096
DEPTH = 1

CHUNK = 64
D_MIX = D_MODEL
D_ATTN = D_MIX // 2
D_REC = D_MIX - D_ATTN
ATTN_HEAD_DIM = 128
N_ATTN_HEADS = D_ATTN // ATTN_HEAD_DIM
LEFT_CHUNKS = 8
BAND = (LEFT_CHUNKS + 1) * CHUNK
MAX_REL = 256
N_REL = 2 * MAX_REL + 1
REC_BLOCKS = 16
REC_BLOCK_DIM = D_REC // REC_BLOCKS
CONV_WIDTH = 4
RG_C = 8.0
PEER_HEADS = 8
PEER_N_KEYS = 128
PEER_N_EXPERTS = PEER_N_KEYS * PEER_N_KEYS
PEER_QDIM = 256
PEER_HALF = PEER_QDIM // 2
PEER_TOPK = 16
PEER_TOKEN_BLOCK = 64
EPS = 1e-6
IN_SPLITS = (D_ATTN, 2 * D_ATTN, 3 * D_ATTN, 3 * D_ATTN + D_REC)
IN_COLS = 3 * D_ATTN + 2 * D_REC

kernel_name = 'hymba_chunk_streaming_rglru_peer'


def rms_norm(x, g):
    xf = x.astype(jnp.float32)
    y = xf * lax.rsqrt(jnp.mean(xf * xf, axis=-1, keepdims=True) + EPS)
    return (y * g.astype(jnp.float32)).astype(x.dtype)


def chunked_band_attention(q, k, v, rel_bias):
    B, S, H, Dh = q.shape
    nc = S // CHUNK
    pad = LEFT_CHUNKS * CHUNK
    kp = jnp.pad(k, ((0, 0), (pad, 0), (0, 0), (0, 0)))
    vp = jnp.pad(v, ((0, 0), (pad, 0), (0, 0), (0, 0)))
    q_off = jnp.arange(CHUNK)[:, None]
    k_off = jnp.arange(BAND)[None, :] - pad
    rel = jnp.clip(q_off - k_off, -MAX_REL, MAX_REL) + MAX_REL
    bias = rel_bias[:, rel].astype(jnp.float32)
    scale = Dh ** -0.5
    neg = jnp.finfo(jnp.float32).min
    qc = q.reshape(B, nc, CHUNK, H, Dh).transpose(1, 0, 2, 3, 4)

    def one_chunk(args):
        q_blk, c = args
        start = c * CHUNK
        kb = lax.dynamic_slice_in_dim(kp, start, BAND, axis=1)
        vb = lax.dynamic_slice_in_dim(vp, start, BAND, axis=1)
        s = jnp.einsum('bqhd,bkhd->bhqk', q_blk, kb,
                       preferred_element_type=jnp.float32) * scale + bias
        valid = (start + jnp.arange(BAND)) >= pad
        s = jnp.where(valid[None, None, None, :], s, neg)
        p = jax.nn.softmax(s, axis=-1)
        return jnp.einsum('bhqk,bkhd->bqhd', p.astype(vb.dtype), vb)

    out = lax.map(one_chunk, (qc, jnp.arange(nc, dtype=jnp.int32)))
    return out.transpose(1, 0, 2, 3, 4).reshape(B, S, H * Dh)


def causal_depthwise_conv(x, w, b):
    S = x.shape[1]
    xp = jnp.pad(x, ((0, 0), (CONV_WIDTH - 1, 0), (0, 0)))
    out = b
    for tap in range(CONV_WIDTH):
        out = out + xp[:, tap:tap + S] * w[tap]
    return out


def rg_lru(x, w_a, b_a, w_x, b_x, lam):
    B, S, C = x.shape
    xb = x.reshape(B, S, REC_BLOCKS, REC_BLOCK_DIM)
    r = jax.nn.sigmoid(jnp.einsum('bsnc,ncd->bsnd', xb, w_a).reshape(B, S, C) + b_a)
    i = jax.nn.sigmoid(jnp.einsum('bsnc,ncd->bsnd', xb, w_x).reshape(B, S, C) + b_x)
    log_a = (-RG_C * r.astype(jnp.float32)) * jax.nn.softplus(-lam.astype(jnp.float32))
    a = jnp.exp(log_a)
    mult = jnp.sqrt(-jnp.expm1(2.0 * log_a))
    u = mult * (i * x).astype(jnp.float32)

    def combine(left, right):
        a1, b1 = left
        a2, b2 = right
        return a1 * a2, a2 * b1 + b2

    _, h = lax.associative_scan(combine, (a, u), axis=1)
    return h.astype(x.dtype)


def peer_ffn(h, w_pq, keys_1, keys_2, u_tab, v_tab):
    B, S, D = h.shape
    q = (h @ w_pq).reshape(B, S, PEER_HEADS, 2, PEER_HALF)
    s1 = jnp.einsum('bshd,hnd->bshn', q[..., 0, :], keys_1, preferred_element_type=jnp.float32)
    s2 = jnp.einsum('bshd,hnd->bshn', q[..., 1, :], keys_2, preferred_element_type=jnp.float32)
    t1, i1 = lax.top_k(s1, PEER_TOPK)
    t2, i2 = lax.top_k(s2, PEER_TOPK)
    cand = (t1[..., :, None] + t2[..., None, :]).reshape(B, S, PEER_HEADS, PEER_TOPK * PEER_TOPK)
    ts, ti = lax.top_k(cand, PEER_TOPK)
    ia = ti // PEER_TOPK
    ib = ti % PEER_TOPK
    expert = (jnp.take_along_axis(i1, ia, axis=-1) * PEER_N_KEYS
              + jnp.take_along_axis(i2, ib, axis=-1))
    gate = jax.nn.softmax(ts, axis=-1)
    k_all = PEER_HEADS * PEER_TOPK
    nb = (B * S) // PEER_TOKEN_BLOCK
    hb = h.reshape(nb, PEER_TOKEN_BLOCK, D)
    eb = expert.reshape(nb, PEER_TOKEN_BLOCK, k_all)
    gb = gate.reshape(nb, PEER_TOKEN_BLOCK, k_all)

    def block(args):
        hx, ex, gx = args
        u_sel = u_tab[ex]
        act = jax.nn.gelu(jnp.einsum('td,tkd->tk', hx, u_sel, preferred_element_type=jnp.float32))
        w = (gx * act).astype(hx.dtype)
        return jnp.einsum('tk,tkd->td', w, v_tab[ex])

    y = lax.map(block, (hb, eb, gb))
    return y.reshape(B, S, D)


def hybrid_layer(x, g_norm1, w_in, g_q_norm, g_k_norm, rel_bias, conv_w, conv_b,
                 w_rg_a, b_rg_a, w_rg_x, b_rg_x, rg_lambda, g_attn_out, g_rec_out,
                 w_out, g_norm2, w_peer_q, peer_keys_1, peer_keys_2, peer_u, peer_v):
    B, S, _ = x.shape
    h = rms_norm(x, g_norm1)
    proj = h @ w_in
    q, k, v, x_rec, y_rec = jnp.split(proj, IN_SPLITS, axis=-1)
    q = rms_norm(q.reshape(B, S, N_ATTN_HEADS, ATTN_HEAD_DIM), g_q_norm)
    k = rms_norm(k.reshape(B, S, N_ATTN_HEADS, ATTN_HEAD_DIM), g_k_norm)
    v = v.reshape(B, S, N_ATTN_HEADS, ATTN_HEAD_DIM)
    attn = chunked_band_attention(q, k, v, rel_bias)
    xr = causal_depthwise_conv(x_rec, conv_w, conv_b)
    rec = rg_lru(xr, w_rg_a, b_rg_a, w_rg_x, b_rg_x, rg_lambda) * jax.nn.gelu(y_rec)
    mixed = jnp.concatenate([rms_norm(attn, g_attn_out), rms_norm(rec, g_rec_out)], axis=-1)
    x = x + mixed @ w_out
    x = x + peer_ffn(rms_norm(x, g_norm2), w_peer_q, peer_keys_1, peer_keys_2, peer_u, peer_v)
    return x


def setup_inputs(seed: int = 0) -> dict:
    key = jax.random.key(seed)
    ks = jax.random.split(key, 24)
    f32 = jnp.float32
    L = DEPTH

    def nrm(k, shape, scale):
        return jax.random.normal(k, shape, f32) * scale

    def gain(k, shape):
        return 1.0 + 0.01 * jax.random.normal(k, shape, f32)

    a8 = jax.random.uniform(ks[12], (L, D_REC), f32, 0.9, 0.999)
    s = a8 ** (1.0 / RG_C)
    rg_lambda = jnp.log(s) - jnp.log1p(-s)
    return {
        'x': jax.random.normal(ks[0], (BATCH, SEQ, D_MODEL), f32),
        'g_norm1': gain(ks[1], (L, D_MODEL)),
        'w_in': nrm(ks[2], (L, D_MODEL, IN_COLS), D_MODEL ** -0.5),
        'g_q_norm': gain(ks[3], (L, ATTN_HEAD_DIM)),
        'g_k_norm': gain(ks[4], (L, ATTN_HEAD_DIM)),
        'rel_bias': nrm(ks[5], (L, N_ATTN_HEADS, N_REL), 0.1),
        'conv_w': nrm(ks[6], (L, CONV_WIDTH, D_REC), CONV_WIDTH ** -0.5),
        'conv_b': nrm(ks[7], (L, D_REC), 0.01),
        'w_rg_a': nrm(ks[8], (L, REC_BLOCKS, REC_BLOCK_DIM, REC_BLOCK_DIM), REC_BLOCK_DIM ** -0.5),
        'b_rg_a': nrm(ks[9], (L, D_REC), 0.01),
        'w_rg_x': nrm(ks[10], (L, REC_BLOCKS, REC_BLOCK_DIM, REC_BLOCK_DIM), REC_BLOCK_DIM ** -0.5),
        'b_rg_x': nrm(ks[11], (L, D_REC), 0.01),
        'rg_lambda': rg_lambda,
        'g_attn_out': gain(ks[13], (L, D_ATTN)),
        'g_rec_out': gain(ks[14], (L, D_REC)),
        'w_out': nrm(ks[15], (L, D_MIX, D_MODEL), D_MIX ** -0.5),
        'g_norm2': gain(ks[16], (L, D_MODEL)),
        'w_peer_q': nrm(ks[17], (L, D_MODEL, PEER_HEADS * PEER_QDIM), D_MODEL ** -0.5),
        'peer_keys_1': nrm(ks[18], (L, PEER_HEADS, PEER_N_KEYS, PEER_HALF), PEER_HALF ** -0.5),
        'peer_keys_2': nrm(ks[19], (L, PEER_HEADS, PEER_N_KEYS, PEER_HALF), PEER_HALF ** -0.5),
        'peer_u': nrm(ks[20], (L, PEER_N_EXPERTS, D_MODEL), D_MODEL ** -0.5),
        'peer_v': nrm(ks[21], (L, PEER_N_EXPERTS, D_MODEL), PEER_HEADS ** -0.5),
    }


def reference(x, g_norm1, w_in, g_q_norm, g_k_norm, rel_bias, conv_w, conv_b,
              w_rg_a, b_rg_a, w_rg_x, b_rg_x, rg_lambda, g_attn_out, g_rec_out,
              w_out, g_norm2, w_peer_q, peer_keys_1, peer_keys_2, peer_u, peer_v):
    for l in range(DEPTH):
        x = hybrid_layer(x, g_norm1[l], w_in[l], g_q_norm[l], g_k_norm[l], rel_bias[l],
                         conv_w[l], conv_b[l], w_rg_a[l], b_rg_a[l], w_rg_x[l], b_rg_x[l],
                         rg_lambda[l], g_attn_out[l], g_rec_out[l], w_out[l], g_norm2[l],
                         w_peer_q[l], peer_keys_1[l], peer_keys_2[l], peer_u[l], peer_v[l])
    return x
```

```cpp
#include <hip/hip_runtime.h>
#include <cstdio>
#include <cstdint>

#define LAS __attribute__((address_space(3)))
#define RLX_AGENT __ATOMIC_RELAXED, __HIP_MEMORY_SCOPE_AGENT

constexpr int BATCH = 4, SEQ = 4096, TOK = BATCH * SEQ, DM = 4096, DATT = 2048, DREC = 2048, NIN = 10240, NHEAD = 16, HD = 128, CHUNK = 64, NREL = 513;
constexpr int NRB = 16, RBD = 128, PH = 8, PNK = 128, PQD = 256, PTOPK = 16, PQN = PH * PQD  , NEXP = 16384;
constexpr float EPS = 1e-6f, LOG2E = 1.4426950408889634f;

constexpr size_t MB = 1024ull * 1024ull;
constexpr size_t WS_CTL = 0;
constexpr size_t CTL_BYTES = 64 * 1024;
constexpr size_t WS_SMALL = WS_CTL + CTL_BYTES;
constexpr size_t SM_RSTD1 = 0;
constexpr size_t SM_ASSQ = SM_RSTD1 + (size_t)TOK * 4;
constexpr size_t SM_RSSQ = SM_ASSQ + (size_t)TOK * 16 * 4;
constexpr size_t SM_SSQ2 = SM_RSSQ + (size_t)TOK * 16 * 4;
constexpr size_t SM_WGT = SM_SSQ2 + (size_t)TOK * 64 * 4;
constexpr size_t SM_KEYS = SM_WGT + (size_t)16 * 2 * 128 * 128 * 2;
constexpr size_t SM_END = SM_KEYS + (size_t)2 * 8 * 128 * 128 * 2;
constexpr size_t WS_XB = WS_SMALL + 8 * MB;
constexpr size_t WS_WIN = WS_XB + 128 * MB;
constexpr size_t WS_WOUT = WS_WIN + 80 * MB;
constexpr size_t WS_WPQ = WS_WOUT + 32 * MB;
constexpr size_t WS_UB = WS_WPQ + 16 * MB;
constexpr size_t WS_VB = WS_UB + 128 * MB;
constexpr size_t WS_Q = WS_VB + 128 * MB;
constexpr size_t WS_K = WS_Q + 64 * MB;
constexpr size_t WS_V = WS_K + 64 * MB;
constexpr size_t WS_XR = WS_V + 64 * MB;
constexpr size_t WS_GY = WS_XR + 64 * MB;
constexpr size_t WS_MIX = WS_GY + 64 * MB;
constexpr size_t WS_END = WS_MIX + 128 * MB;
static_assert(SM_END <= 8 * MB, "small region");

constexpr int CW_BAR = 0;
constexpr int CW_QUEUE = 4096;
constexpr int CW_TMO = 4160;

constexpr int NWAVES = 8, NTHREADS = 512;
constexpr int LDS_BYTES = 147456;
constexpr int LDS_XCH = 131072;
constexpr int LDS_MISC = 143360;

typedef unsigned short bf16_t;
typedef short bf16x8 __attribute__((ext_vector_type(8)));
typedef short s16x4 __attribute__((ext_vector_type(4)));
typedef float f32x4 __attribute__((ext_vector_type(4)));
typedef float f32x16 __attribute__((ext_vector_type(16)));
typedef unsigned u32x4 __attribute__((ext_vector_type(4)));
typedef __attribute__((ext_vector_type(2))) __bf16 bf16x2_t;

__device__ __forceinline__ unsigned cvtpk(float lo, float hi) { unsigned r; asm volatile("v_cvt_pk_bf16_f32 %0, %1, %2" : "=v"(r) : "v"(lo), "v"(hi)); return r; }
__device__ __forceinline__ float bf_lo(unsigned w) { return __uint_as_float(w << 16); }
__device__ __forceinline__ float bf_hi(unsigned w) { return __uint_as_float(w & 0xffff0000u); }
__device__ __forceinline__ float bf2f(bf16_t b) { return __uint_as_float(((unsigned)b) << 16); }
__device__ __forceinline__ float wave_sum(float v) {
#pragma unroll
    for (int o = 32; o >= 1; o >>= 1) v += __shfl_xor(v, o);
    return v;
}
__device__ __forceinline__ float dot2bf(unsigned a, unsigned b, float acc) { return __builtin_amdgcn_fdot2_f32_bf16(__builtin_bit_cast(bf16x2_t, a), __builtin_bit_cast(bf16x2_t, b), acc, false); }
__device__ __forceinline__ float gelu_tanh(float x) {
    const float z = x * (0.7978845608028654f + 0.035677408136300125f * x * x);
    const float e = __builtin_amdgcn_exp2f(-2.0f * LOG2E * z);
    return x * __builtin_amdgcn_rcpf(1.0f + e);
}
__device__ __forceinline__ float sigmoid_f(float x) { return __builtin_amdgcn_rcpf(1.0f + __builtin_amdgcn_exp2f(-LOG2E * x)); }

#define XB_TMO      128
#define XB_XCNT(j)  (256  + 64 * (j))
#define XB_XSUB(j)  (1280 + 64 * (j))
#define XB_XGEN(j)  (2304 + 64 * (j))
#define XB_TOP      3328
#define XB_TOPGEN   3392
#define XCD_BAR_WORDS 3456
#define XB_SPIN_CAP (1u << 18)

__device__ __forceinline__ unsigned xb_ld(unsigned* p)              { return __hip_atomic_load(p, __ATOMIC_RELAXED, __HIP_MEMORY_SCOPE_AGENT); }
__device__ __forceinline__ unsigned xb_add(unsigned* p, unsigned v) { return __hip_atomic_fetch_add(p, v, __ATOMIC_RELAXED, __HIP_MEMORY_SCOPE_AGENT); }
__device__ __forceinline__ unsigned xb_xcc_id() { return (unsigned)__builtin_amdgcn_s_getreg((3 << 11) | 20) & 0xFu; }
#define XB_SPIN(cond, bar) do { unsigned _sp = 0; while (cond) { __builtin_amdgcn_s_sleep(1); \
    if ((++_sp & 255u) == 0u) { if (xb_ld(&(bar)[XB_TMO])) break; if (_sp > XB_SPIN_CAP) { atomicAdd(&(bar)[XB_TMO], 1u); break; } } } } while (0)

struct XcdBarrier {
    unsigned* bar; unsigned x;
    volatile LAS unsigned* st;
};

__device__ __forceinline__ XcdBarrier xcd_barrier_post(unsigned* bar, volatile LAS unsigned* st) {
    XcdBarrier b; b.bar = bar; b.x = xb_xcc_id(); b.st = st;
    if (threadIdx.x == 0) (void)xb_add(&bar[XB_XCNT(b.x)], 1u);
    return b;
}
__device__ __forceinline__ void xcd_barrier_complete(unsigned* bar, unsigned x, unsigned& nloc, unsigned& nx) {
    const unsigned G = gridDim.x * gridDim.y * gridDim.z;
    unsigned sum, cnt, mine, sp = 0u;
    for (;;) {
        sum = 0u; cnt = 0u; mine = 0u;
#pragma unroll
        for (unsigned j = 0; j < 16; ++j) { const unsigned c = xb_ld(&bar[XB_XCNT(j)]); sum += c; cnt += (c > 0u) ? 1u : 0u; mine = (j == x) ? c : mine; }
        if (sum == G) break;
        __builtin_amdgcn_s_sleep(1);
        if ((++sp & 255u) == 0u) { if (xb_ld(&bar[XB_TMO])) break; if (sp > XB_SPIN_CAP) { atomicAdd(&bar[XB_TMO], 1u); break; } }
    }
    nloc = mine > 0u ? mine : 1u; nx = cnt > 0u ? cnt : 1u;
}

__device__ __forceinline__ void xcd_barrier(const XcdBarrier& b) {
    asm volatile("s_waitcnt vmcnt(0)" ::: "memory");
    __syncthreads();
    if (threadIdx.x == 0) {
        unsigned* bar = b.bar;
        __builtin_amdgcn_s_waitcnt(0);
        unsigned nloc = b.st[0], nx = b.st[1];
        if (nloc == 0u) { xcd_barrier_complete(bar, b.x, nloc, nx); b.st[0] = nloc; b.st[1] = nx; }
        const unsigned old = xb_add(&bar[XB_XSUB(b.x)], 1u);
        const unsigned gen = old / nloc;
        if (old + 1u == (gen + 1u) * nloc) {
            __builtin_amdgcn_fence(__ATOMIC_RELEASE, "agent");
            asm volatile("s_waitcnt vmcnt(0)" ::: "memory");
            const unsigned og = xb_add(&bar[XB_TOP], 1u);
            const unsigned tg = og / nx;
            if (og + 1u == (tg + 1u) * nx) xb_add(&bar[XB_TOPGEN], 1u);
            else XB_SPIN(xb_ld(&bar[XB_TOPGEN]) == tg, bar);
            __builtin_amdgcn_fence(__ATOMIC_ACQUIRE, "agent");
            xb_add(&bar[XB_XGEN(b.x)], 1u);
            asm volatile("s_waitcnt vmcnt(0)" ::: "memory");
        } else {
            XB_SPIN(xb_ld(&bar[XB_XGEN(b.x)]) == gen, bar);
            __builtin_amdgcn_fence(__ATOMIC_ACQUIRE, "agent");
            asm volatile("s_waitcnt vmcnt(0)" ::: "memory");
        }
    }
    __syncthreads();
}
namespace pg8 {
#define PG8_LAS __attribute__((address_space(3)))
typedef unsigned short bf16_t;
typedef short bf16x8 __attribute__((ext_vector_type(8)));
typedef float f32x4 __attribute__((ext_vector_type(4)));
typedef unsigned u32x4 __attribute__((ext_vector_type(4)));
constexpr int BM = 256, BK = 64, HALF = 128, HTB = HALF * BK * 2  , STAGE_BYTES = 8 * HTB, NXCD = 8, WGM = 8;

__host__ __device__ __forceinline__ int lds_byte(int r, int c) { const int st = (r >> 4) * 2 + (c >> 5), rr = r & 15, cc = c & 31, ob = rr * 64 + cc * 2; return st * 1024 + (ob ^ (((ob >> 9) & 1) << 5)); }
__host__ __device__ __forceinline__ void stage_rc(int b, int& R, int& C) { const int st = b / 1024, sb = b % 1024, swz = sb ^ (((sb >> 9) & 1) << 5); R = (st >> 1) * 16 + swz / 64; C = (st & 1) * 32 + (swz % 64) / 2; }
__host__ __device__ __forceinline__ int perm32(int rho) { const int n = rho >> 4, i = rho & 15; return 8 * (i >> 2) + 4 * n + (i & 3); }

struct Unit { int pm, pn; };
struct Gemm { const bf16_t* A; const bf16_t* Bt; int M, N, K; };

struct StaticOrder {
    int nM, nN, nwg, G, c;
    __host__ __device__ void init(int M, int N, int G_, int c_) { nM = M / BM; nN = N / BM; nwg = nM * nN; G = G_; c = c_; }
    __host__ __device__ bool next(int i, Unit& u) const {
        const long L = (long)i * G + c; if (L >= nwg) return false;
        int wgid = (int)L; { const int q = nwg / NXCD, r = nwg % NXCD, xcd = wgid % NXCD, off = wgid / NXCD; wgid = (xcd < r ? xcd * (q + 1) : r * (q + 1) + (xcd - r) * q) + off; }
        const int nig = WGM * nN, gid = wgid / nig, fm = gid * WGM, gsz = (nM - fm) < WGM ? (nM - fm) : WGM;
        u.pm = fm + ((wgid % nig) % gsz); u.pn = (wgid % nig) / gsz; return true;
    }
    __device__ __forceinline__ void a_ready(const Unit&) const {}
    __device__ __forceinline__ void done(const Unit&) const {}
};
struct CountedOrder : StaticOrder {
    const unsigned* ready; unsigned need; unsigned* tmo;
    __device__ __forceinline__ void a_ready(const Unit& u) const {
        if (threadIdx.x < 64) {
            const unsigned long long t0 = __builtin_amdgcn_s_memrealtime(); unsigned polls = 0;
            while ((unsigned)__builtin_amdgcn_readfirstlane(__hip_atomic_load(ready + 64 * u.pm, __ATOMIC_RELAXED, __HIP_MEMORY_SCOPE_AGENT)) < need) {
                if ((++polls & 255u) == 0u && __builtin_amdgcn_readfirstlane(__hip_atomic_load(tmo, __ATOMIC_RELAXED, __HIP_MEMORY_SCOPE_AGENT)) != 0u) break;
                if (__builtin_amdgcn_s_memrealtime() - t0 > 2000000ull) {
                    if (threadIdx.x == 0) { unsigned expect = 0u; __hip_atomic_compare_exchange_strong(tmo + 1, &expect, 0x600u | (unsigned)(u.pm & 0xff), __ATOMIC_RELAXED, __ATOMIC_RELAXED, __HIP_MEMORY_SCOPE_AGENT); __hip_atomic_store(tmo, 1u, __ATOMIC_RELAXED, __HIP_MEMORY_SCOPE_AGENT); }
                    break; }
                __builtin_amdgcn_s_sleep(2); }
            __builtin_amdgcn_fence(__ATOMIC_ACQUIRE, "agent");
            asm volatile("s_waitcnt vmcnt(0)" ::: "memory");
        }
#if !defined(BROKEN_HOOK_NO_BARRIER)
        asm volatile("" ::: "memory"); __builtin_amdgcn_s_barrier(); asm volatile("" ::: "memory");
#endif
    }
};

__device__ __forceinline__ unsigned cvt_pk_bf16(float lo, float hi) { unsigned r; asm volatile("v_cvt_pk_bf16_f32 %0, %1, %2" : "=v"(r) : "v"(lo), "v"(hi)); return r; }
typedef float f32x2 __attribute__((ext_vector_type(2)));
__device__ __forceinline__ f32x2 gelu_pk(f32x2 v) {
    const f32x2 av = __builtin_elementwise_abs(v), d = av * 0.2316418882f + 1.0f;
    f32x2 t; t.x = __builtin_amdgcn_rcpf(d.x); t.y = __builtin_amdgcn_rcpf(d.y);
    f32x2 q = t * 0.5307027145f + (-0.7265760135f); q = q * t + 0.7107068705f; q = q * t + (-0.142248368f); q = q * t + 0.127414796f; q = q * t;
    const f32x2 s = (v * v) * (-0.72134752044f);
    f32x2 e; e.x = __builtin_amdgcn_exp2f(s.x); e.y = __builtin_amdgcn_exp2f(s.y);
    const f32x2 m = v * (q * e), r = v - m;
    f32x2 o; o.x = v.x < 0.f ? m.x : r.x; o.y = v.y < 0.f ? m.y : r.y; return o;
}


struct EpiProj {
    static constexpr bool PERM = true, AFTER_DRAIN = false;
    bf16_t* outq; size_t reg_stride; const float* rstd1; const float* gq; const float* gk; PG8_LAS float* xch;
    __device__ __forceinline__ void operator()(const f32x4 (&acc)[2][2][4][2], const Unit& u, int wr, int wc, int fr, int fq) const {
        const int region = u.pn >> 3, pl = u.pn & 7;
        bf16_t* base = outq + (size_t)region * reg_stride;
        const int row0 = u.pm * BM + wr * 64 + fr;
        const int colL = pl * 256 + wc * 32 + 8 * fq;
        float rsv[2][4];
#pragma unroll
        for (int ai = 0; ai < 2; ++ai)
#pragma unroll
            for (int m = 0; m < 4; ++m) rsv[ai][m] = rstd1[row0 + ai * HALF + m * 16];
        if (region <= 1) {
            const float* g = (region == 0) ? gq : gk;
            const f32x4 g0 = *(const f32x4*)(g + wc * 32 + 8 * fq), g1 = *(const f32x4*)(g + wc * 32 + 8 * fq + 4);
#pragma unroll
            for (int ai = 0; ai < 2; ++ai)
#pragma unroll
                for (int m = 0; m < 4; ++m)
#pragma unroll
                    for (int bj = 0; bj < 2; ++bj) {
                        const f32x4 v0 = acc[ai][bj][m][0], v1 = acc[ai][bj][m][1];
                        float ss = (v0[0] * v0[0] + v0[1] * v0[1]) + (v0[2] * v0[2] + v0[3] * v0[3]) + (v1[0] * v1[0] + v1[1] * v1[1]) + (v1[2] * v1[2] + v1[3] * v1[3]);
                        ss *= rsv[ai][m] * rsv[ai][m];
                        ss += __shfl_xor(ss, 16); ss += __shfl_xor(ss, 32);
                        if (fq == 0) xch[((((wr * 2 + ai) * 4 + m) * 2 + bj) * 16 + fr) * 4 + wc] = ss;
                    }
            asm volatile("s_waitcnt lgkmcnt(0)" ::: "memory"); __builtin_amdgcn_s_barrier(); asm volatile("" ::: "memory");
#pragma unroll
            for (int ai = 0; ai < 2; ++ai)
#pragma unroll
                for (int m = 0; m < 4; ++m) {
                    bf16_t* rowp = base + (size_t)(row0 + ai * HALF + m * 16) * 2048 + colL;
#pragma unroll
                    for (int bj = 0; bj < 2; ++bj) {
                        const f32x4 p = *(const PG8_LAS f32x4*)(xch + ((((wr * 2 + ai) * 4 + m) * 2 + bj) * 16 + fr) * 4);
                        const float rn = __builtin_amdgcn_rsqf(((p[0] + p[1]) + (p[2] + p[3])) * (1.0f / 128.0f) + 1e-6f) * rsv[ai][m];
                        const f32x4 v0 = acc[ai][bj][m][0] * rn * g0, v1 = acc[ai][bj][m][1] * rn * g1;
                        u32x4 w; w.x = cvt_pk_bf16(v0[0], v0[1]); w.y = cvt_pk_bf16(v0[2], v0[3]); w.z = cvt_pk_bf16(v1[0], v1[1]); w.w = cvt_pk_bf16(v1[2], v1[3]);
                        *(u32x4*)(rowp + bj * HALF) = w;
                    }
                }
        } else {
#pragma unroll
            for (int ai = 0; ai < 2; ++ai)
#pragma unroll
                for (int m = 0; m < 4; ++m) {
                    bf16_t* rowp = base + (size_t)(row0 + ai * HALF + m * 16) * 2048 + colL;
                    const float rs = rsv[ai][m];
#pragma unroll
                    for (int bj = 0; bj < 2; ++bj) {
                        f32x4 v0 = acc[ai][bj][m][0] * rs, v1 = acc[ai][bj][m][1] * rs;
                        if (region == 4) {
#pragma unroll
                            for (int j = 0; j < 4; ++j) { v0[j] = gelu_tanh(v0[j]); v1[j] = gelu_tanh(v1[j]); }
                        }
                        u32x4 w; w.x = cvt_pk_bf16(v0[0], v0[1]); w.y = cvt_pk_bf16(v0[2], v0[3]); w.z = cvt_pk_bf16(v1[0], v1[1]); w.w = cvt_pk_bf16(v1[2], v1[3]);
                        *(u32x4*)(rowp + bj * HALF) = w;
                    }
                }
        }
    }
};
struct EpiOut {
    static constexpr bool PERM = true, AFTER_DRAIN = false;
    const float* x; float* out; bf16_t* x2b; float* ssq2;
    __device__ __forceinline__ void operator()(const f32x4 (&acc)[2][2][4][2], const Unit& u, int wr, int wc, int fr, int fq) const {
        const int row0 = u.pm * BM + wr * 64 + fr, col0 = u.pn * BM + wc * 32 + 8 * fq;
#pragma unroll
        for (int ai = 0; ai < 2; ++ai)
#pragma unroll
            for (int m = 0; m < 4; ++m) {
                const size_t row = (size_t)(row0 + ai * HALF + m * 16);
                float ss = 0.f;
#pragma unroll
                for (int bj = 0; bj < 2; ++bj) {
                    const size_t o = row * DM + col0 + bj * HALF;
                    const f32x4 xa = *(const f32x4*)(x + o), xb = *(const f32x4*)(x + o + 4);
                    const f32x4 v0 = acc[ai][bj][m][0] + xa, v1 = acc[ai][bj][m][1] + xb;
                    *(f32x4*)(out + o) = v0; *(f32x4*)(out + o + 4) = v1;
                    u32x4 w; w.x = cvt_pk_bf16(v0[0], v0[1]); w.y = cvt_pk_bf16(v0[2], v0[3]); w.z = cvt_pk_bf16(v1[0], v1[1]); w.w = cvt_pk_bf16(v1[2], v1[3]);
                    *(u32x4*)(x2b + o) = w;
                    ss += (v0[0] * v0[0] + v0[1] * v0[1]) + (v0[2] * v0[2] + v0[3] * v0[3]) + (v1[0] * v1[0] + v1[1] * v1[1]) + (v1[2] * v1[2] + v1[3] * v1[3]);
                }
                ss += __shfl_xor(ss, 16); ss += __shfl_xor(ss, 32);
                if (fq == 0) ssq2[row * 64 + u.pn * 4 + wc] = ss;
            }
    }
};
struct EpiPq {
    static constexpr bool PERM = true, AFTER_DRAIN = false;
    bf16_t* pq;
    __device__ __forceinline__ void operator()(const f32x4 (&acc)[2][2][4][2], const Unit& u, int wr, int wc, int fr, int fq) const {
        const int row0 = u.pm * BM + wr * 64 + fr, col0 = u.pn * BM + wc * 32 + 8 * fq;
#pragma unroll
        for (int ai = 0; ai < 2; ++ai)
#pragma unroll
            for (int m = 0; m < 4; ++m) {
                bf16_t* rowp = pq + (size_t)(row0 + ai * HALF + m * 16) * PQN + col0;
#pragma unroll
                for (int bj = 0; bj < 2; ++bj) {
                    const f32x4 v0 = acc[ai][bj][m][0], v1 = acc[ai][bj][m][1];
                    u32x4 w; w.x = cvt_pk_bf16(v0[0], v0[1]); w.y = cvt_pk_bf16(v0[2], v0[3]); w.z = cvt_pk_bf16(v1[0], v1[1]); w.w = cvt_pk_bf16(v1[2], v1[3]);
                    *(u32x4*)(rowp + bj * HALF) = w;
                }
            }
    }
};
template <class Epi, class Sched, bool STAMP = false>
__device__ __forceinline__ void gemm_phase(PG8_LAS unsigned char* lds, const Gemm g, const Sched& S, const Epi& E, unsigned long long* stamps) {
    const int tid = threadIdx.x, wid = __builtin_amdgcn_readfirstlane(tid >> 6), lane = tid & 63, wr = wid >> 2, wc = wid & 3, fr = lane & 15, fq = lane >> 4;
    const int K = g.K, nt = K / BK;
    int ts_lo = 0, ts_hi = 0, nts = 0; const unsigned long long rt_entry = STAMP ? (unsigned long long)wall_clock64() : 0ull;
#define PG8_STAMP() do { if (STAMP && wid == 0 && nts < 64) { const unsigned long long _c = (unsigned long long)clock64(); \
        ts_lo = (lane == nts) ? (int)(unsigned)_c : ts_lo; ts_hi = (lane == nts) ? (int)(unsigned)(_c >> 32) : ts_hi; ++nts; } } while (0)
    PG8_STAMP();
    unsigned voffA[2], voffB[2];
#pragma unroll
    for (int i = 0; i < 2; ++i) { int R, C; stage_rc(tid * 16 + i * 8192, R, C); const int Rb = Epi::PERM ? ((R & ~31) + perm32(R & 31)) : R;
        voffA[i] = (unsigned)(R * K + C) * 2u; voffB[i] = (unsigned)(Rb * K + C) * 2u; }
    const size_t kstep = (size_t)(BK * 2);
    const size_t hstep = (size_t)HALF * K * 2;
    const size_t tstep = 2 * hstep;
    const unsigned ldsw = (unsigned)wid * 1024u;
    const int aoff = lds_byte(wr * 64 + fr, fq * 8), boff = lds_byte(wc * 32 + fr, fq * 8);
#define PG8_SA(b, h) (((b) * 2 + (h)) * HTB)
#define PG8_SB(b, h) ((4 + (b) * 2 + (h)) * HTB)
#define PG8_STAGE(bufoff, gbase, voff) do { _Pragma("unroll") for (int _i = 0; _i < 2; ++_i) \
        __builtin_amdgcn_global_load_lds((const unsigned*)((const char*)(gbase) + (voff)[_i]), (PG8_LAS unsigned*)(lds + (bufoff) + ldsw + _i * 8192), 16, 0, 0); } while (0)
#define PG8_LDA(dst, b, h) do { _Pragma("unroll") for (int m = 0; m < 4; ++m) _Pragma("unroll") for (int k = 0; k < 2; ++k) dst[m][k] = *(const PG8_LAS bf16x8*)(lds + PG8_SA(b, h) + aoff + m * 2048 + k * 1024); } while (0)
#define PG8_LDB(dst, b, h) do { _Pragma("unroll") for (int n = 0; n < 2; ++n) _Pragma("unroll") for (int k = 0; k < 2; ++k) dst[n][k] = *(const PG8_LAS bf16x8*)(lds + PG8_SB(b, h) + boff + n * 2048 + k * 1024); } while (0)
#define PG8_MMA(ai, bj, At, Bt) do { __builtin_amdgcn_s_setprio(1); _Pragma("unroll") for (int m = 0; m < 4; ++m) _Pragma("unroll") for (int n = 0; n < 2; ++n) _Pragma("unroll") for (int k = 0; k < 2; ++k) \
        acc[ai][bj][m][n] = __builtin_amdgcn_mfma_f32_16x16x32_bf16(Bt[n][k], At[m][k], acc[ai][bj][m][n], 0, 0, 0); __builtin_amdgcn_s_setprio(0); } while (0)
#define PG8_WAIT_V(n) asm volatile("s_waitcnt vmcnt(" #n ")" ::: "memory")
#define PG8_WAIT_L(n) asm volatile("s_waitcnt lgkmcnt(" #n ")" ::: "memory")
#define PG8_BAR __builtin_amdgcn_s_barrier()
#define PG8_SCHED __builtin_amdgcn_sched_barrier(0)
    Unit cur, nxt; int ui = 0;
    if (!S.next(0, cur)) return;
    f32x4 acc[2][2][4][2];
#pragma unroll
    for (int a = 0; a < 2; ++a)
#pragma unroll
        for (int b = 0; b < 2; ++b)
#pragma unroll
            for (int m = 0; m < 4; ++m)
#pragma unroll
                for (int n = 0; n < 2; ++n) acc[a][b][m][n] = (f32x4){0.f, 0.f, 0.f, 0.f};
    bf16x8 At[4][2], B0[2][2], B1[2][2];
    const char* cA = (const char*)g.A + (size_t)cur.pm * tstep; const char* cB = (const char*)g.Bt + (size_t)cur.pn * tstep;
    S.a_ready(cur);
    PG8_STAGE(PG8_SB(0, 0), cB, voffB); PG8_STAGE(PG8_SA(0, 0), cA, voffA); PG8_STAGE(PG8_SB(0, 1), cB + hstep, voffB); PG8_STAGE(PG8_SA(0, 1), cA + hstep, voffA);
    if (wr == 1) PG8_BAR;
    PG8_WAIT_V(4); PG8_BAR;
    PG8_STAGE(PG8_SB(1, 0), cB + kstep, voffB); PG8_STAGE(PG8_SA(1, 0), cA + kstep, voffA); PG8_STAGE(PG8_SB(1, 1), cB + hstep + kstep, voffB);
    PG8_WAIT_V(6); PG8_BAR;
    PG8_STAMP();
    for (;;) {
        const bool has_next = S.next(ui + 1, nxt);
        const char* nA = has_next ? (const char*)g.A + (size_t)nxt.pm * tstep : cA; const char* nB = has_next ? (const char*)g.Bt + (size_t)nxt.pn * tstep : cB;
        for (int t = 0; t < nt; t += 2) {
            const bool last = (t == nt - 2);
            const char* a1 = cA + (size_t)(t + 1) * kstep;
            const char* a2 = last ? nA : cA + (size_t)(t + 2) * kstep; const char* b2 = last ? nB : cB + (size_t)(t + 2) * kstep;
            const char* a3 = a2 + kstep; const char* b3 = b2 + kstep;
            if (last && has_next) S.a_ready(nxt);
            PG8_LDB(B0, 0, 0); PG8_SCHED; PG8_LDA(At, 0, 0); PG8_STAGE(PG8_SA(1, 1), a1 + hstep, voffA);
            PG8_WAIT_L(8); PG8_BAR; PG8_WAIT_L(0); PG8_MMA(0, 0, At, B0); PG8_BAR; PG8_SCHED;
            PG8_LDB(B1, 0, 1); PG8_STAGE(PG8_SB(0, 0), b2, voffB);
            PG8_BAR; PG8_WAIT_L(0); PG8_MMA(0, 1, At, B1); PG8_BAR;
            PG8_LDA(At, 0, 1); PG8_STAGE(PG8_SA(0, 0), a2, voffA);
            PG8_BAR; PG8_WAIT_L(0); PG8_MMA(1, 0, At, B0); PG8_BAR; PG8_SCHED;
            PG8_STAGE(PG8_SB(0, 1), b2 + hstep, voffB);
            PG8_WAIT_V(6); PG8_BAR; PG8_MMA(1, 1, At, B1); PG8_BAR;
            PG8_LDB(B0, 1, 0); PG8_SCHED; PG8_LDA(At, 1, 0); PG8_STAGE(PG8_SA(0, 1), a2 + hstep, voffA);
            PG8_WAIT_L(8); PG8_BAR; PG8_WAIT_L(0); PG8_MMA(0, 0, At, B0); PG8_BAR; PG8_SCHED;
            PG8_LDB(B1, 1, 1); PG8_STAGE(PG8_SB(1, 0), b3, voffB);
            PG8_BAR; PG8_WAIT_L(0); PG8_MMA(0, 1, At, B1); PG8_BAR;
            PG8_LDA(At, 1, 1); PG8_STAGE(PG8_SA(1, 0), a3, voffA);
            PG8_BAR; PG8_WAIT_L(0); PG8_MMA(1, 0, At, B0); PG8_BAR; PG8_SCHED;
            PG8_STAGE(PG8_SB(1, 1), b3 + hstep, voffB);
            PG8_WAIT_V(6); PG8_BAR; PG8_MMA(1, 1, At, B1); PG8_BAR;
        }
        PG8_STAMP();
        if constexpr (!Epi::AFTER_DRAIN) { E(acc, cur, wr, wc, fr, fq); S.done(cur); }
        PG8_STAMP();
        if (!has_next) break;
#pragma unroll
        for (int a = 0; a < 2; ++a)
#pragma unroll
            for (int b = 0; b < 2; ++b)
#pragma unroll
                for (int m = 0; m < 4; ++m)
#pragma unroll
                    for (int n = 0; n < 2; ++n) acc[a][b][m][n] = (f32x4){0.f, 0.f, 0.f, 0.f};
        cur = nxt; cA = nA; cB = nB; ++ui;
    }
    PG8_WAIT_V(0);
    if (wr == 0) PG8_BAR;
    PG8_BAR;
    if constexpr (Epi::AFTER_DRAIN) { E.fused(acc, cur, wr, wc, fr, fq, lds, wid, lane); S.done(cur); }
    PG8_STAMP();
    if (STAMP && wid == 0) { stamps[lane] = lane < nts ? (((unsigned long long)(unsigned)ts_hi << 32) | (unsigned)ts_lo) : 0ull;
        if (lane == 62) stamps[62] = rt_entry; if (lane == 63) stamps[63] = (unsigned long long)wall_clock64(); }
#undef PG8_STAMP
#undef PG8_SA
#undef PG8_SB
#undef PG8_STAGE
#undef PG8_LDA
#undef PG8_LDB
#undef PG8_MMA
#undef PG8_WAIT_V
#undef PG8_WAIT_L
#undef PG8_BAR
#undef PG8_SCHED
}
}

namespace att {
constexpr int LDK = 2048;
constexpr float SCALE = 0.088388347648318440f;
constexpr float THR2 = 8.f * LOG2E;
constexpr int SHM_V = 64 * 128 * 2, SHM_K = SHM_V;
constexpr int OFF_WS = 2 * SHM_V + 2 * SHM_K, OFF_TBL = OFF_WS + NWAVES * 64 * 4, OFF_Q = OFF_TBL + 704 * 4, ATT_LDS = OFF_Q + NWAVES * 8192;
static_assert(OFF_Q % 16 == 0 && ATT_LDS <= LDS_MISC, "attention LDS map");
#define KSWZ(row, colB) ((row) * 256 + ((colB) ^ (((row) & 7) << 4)))
#define SBAR() __builtin_amdgcn_sched_barrier(0)
__device__ __forceinline__ constexpr int crow(int r, int hi) { return (r & 3) + 8 * (r >> 2) + 4 * hi; }
__device__ __forceinline__ constexpr int kc(int r) { return (r & 3) + 8 * (r >> 2); }

__device__ __forceinline__ void partialSM(f32x16& p0, f32x16& p1, float& m_reg, float& alpha, const float* tp) {
    constexpr float C = SCALE * LOG2E;
#pragma unroll
    for (int r = 0; r < 16; ++r) { p0[r] = fmaf(p0[r], C, tp[59 - kc(r)]); p1[r] = fmaf(p1[r], C, tp[27 - kc(r)]); }
    float pmax = p0[0];
#pragma unroll
    for (int r = 1; r < 16; ++r) pmax = fmaxf(pmax, p0[r]);
#pragma unroll
    for (int r = 0; r < 16; ++r) pmax = fmaxf(pmax, p1[r]);
    { auto rr = __builtin_amdgcn_permlane32_swap(__float_as_uint(pmax), __float_as_uint(pmax), false, false);
      pmax = fmaxf(__uint_as_float(rr[0]), __uint_as_float(rr[1])); }
    float mn;
    if (__builtin_expect(__all(pmax - m_reg <= THR2), 1)) { mn = m_reg; alpha = 1.f; }
    else { mn = fmaxf(m_reg, pmax); alpha = __builtin_amdgcn_exp2f(m_reg - mn); m_reg = mn; }
#pragma unroll
    for (int r = 0; r < 16; ++r) { p0[r] = __builtin_amdgcn_exp2f(p0[r] - mn); p1[r] = p1[r] - mn; }
}
__device__ __forceinline__ void finishSM(f32x16& p0, f32x16& p1, float alpha, float& l_reg, bf16x8& pa0, bf16x8& pa1, bf16x8& pa2, bf16x8& pa3) {
#pragma unroll
    for (int r = 0; r < 16; ++r) p1[r] = __builtin_amdgcn_exp2f(p1[r]);
    float ps = 0;
#pragma unroll
    for (int r = 0; r < 16; ++r) ps += p0[r];
#pragma unroll
    for (int r = 0; r < 16; ++r) ps += p1[r];
    { auto rr = __builtin_amdgcn_permlane32_swap(__float_as_uint(ps), __float_as_uint(ps), false, false);
      ps = __uint_as_float(rr[0]) + __uint_as_float(rr[1]); }
    l_reg = l_reg * alpha + ps;
#define PK4(P, BASE, OUT) do { unsigned a0 = cvtpk(P[BASE + 0], P[BASE + 1]), a1 = cvtpk(P[BASE + 2], P[BASE + 3]);   \
    unsigned b0 = cvtpk(P[BASE + 4], P[BASE + 5]), b1 = cvtpk(P[BASE + 6], P[BASE + 7]);                              \
    auto r0 = __builtin_amdgcn_permlane32_swap(a0, b0, false, false); auto r1 = __builtin_amdgcn_permlane32_swap(a1, b1, false, false); \
    u32x4 w = {r0[0], r1[0], r0[1], r1[1]}; OUT = *reinterpret_cast<bf16x8*>(&w); } while (0)
    PK4(p0, 0, pa0); PK4(p0, 8, pa1); PK4(p1, 0, pa2); PK4(p1, 8, pa3);
#undef PK4
}
__device__ __forceinline__ void qkt(f32x16& p0, f32x16& p1, const char* Ks, const char* qs, int r32, int hi) {
    p0 = f32x16{}; p1 = f32x16{};
#pragma unroll
    for (int d0 = 0; d0 < 8; ++d0) { const int cb = (d0 * 16 + hi * 8) * 2;
        const bf16x8 b0 = *reinterpret_cast<const bf16x8*>(Ks + KSWZ(r32, cb));
        const bf16x8 b1 = *reinterpret_cast<const bf16x8*>(Ks + KSWZ(32 + r32, cb));
        const bf16x8 q = *reinterpret_cast<const bf16x8*>(qs + d0 * 1024);
        p0 = __builtin_amdgcn_mfma_f32_32x32x16_bf16(b0, q, p0, 0, 0, 0);
        p1 = __builtin_amdgcn_mfma_f32_32x32x16_bf16(b1, q, p1, 0, 0, 0); }
}
__device__ __forceinline__ int v_st(int k, int c) { const int kk = (k & ~0xC) | ((k & 4) << 1) | ((k & 8) >> 1); return ((kk >> 3) * 4 + (c >> 5)) * 512 + ((kk & 7) * 32 + (c & 31)) * 2; }
__device__ __forceinline__ int v_rd_base(int lane) { return ((lane & 3) << 3) | (((lane >> 2) & 3) << 6) | (((lane >> 4) & 1) << 5) | (((lane >> 5) & 1) << 8); }
constexpr int v_rd_off(int d0, int ks, int half) { return d0 * 512 + ks * 4096 + half * 2048; }
template <int OFF> __device__ __forceinline__ s16x4 tr_read(int vb) {
    s16x4 r; asm volatile("ds_read_b64_tr_b16 %0, %1 offset:%2" : "=&v"(r) : "v"(vb), "i"(OFF) : "memory"); return r;
}
template <int D0> __device__ __forceinline__ void pv_one(f32x16& od, int vb, bf16x8 pa0, bf16x8 pa1, bf16x8 pa2, bf16x8 pa3) {
    const s16x4 l0 = tr_read<v_rd_off(D0, 0, 0)>(vb), h0 = tr_read<v_rd_off(D0, 0, 1)>(vb), l1 = tr_read<v_rd_off(D0, 1, 0)>(vb), h1 = tr_read<v_rd_off(D0, 1, 1)>(vb);
    const s16x4 l2 = tr_read<v_rd_off(D0, 2, 0)>(vb), h2 = tr_read<v_rd_off(D0, 2, 1)>(vb), l3 = tr_read<v_rd_off(D0, 3, 0)>(vb), h3 = tr_read<v_rd_off(D0, 3, 1)>(vb);
    asm volatile("s_waitcnt lgkmcnt(0)" ::: "memory"); SBAR();
#define PKV(L, H) (bf16x8){L[0], L[1], L[2], L[3], H[0], H[1], H[2], H[3]}
    od = __builtin_amdgcn_mfma_f32_32x32x16_bf16(pa0, PKV(l0, h0), od, 0, 0, 0);
    od = __builtin_amdgcn_mfma_f32_32x32x16_bf16(pa1, PKV(l1, h1), od, 0, 0, 0);
    od = __builtin_amdgcn_mfma_f32_32x32x16_bf16(pa2, PKV(l2, h2), od, 0, 0, 0);
    od = __builtin_amdgcn_mfma_f32_32x32x16_bf16(pa3, PKV(l3, h3), od, 0, 0, 0);
#undef PKV
}
__device__ __forceinline__ void pv_d0(f32x16* o, int vb, bf16x8 pa0, bf16x8 pa1, bf16x8 pa2, bf16x8 pa3) {
    pv_one<0>(o[0], vb, pa0, pa1, pa2, pa3); pv_one<1>(o[1], vb, pa0, pa1, pa2, pa3); pv_one<2>(o[2], vb, pa0, pa1, pa2, pa3); pv_one<3>(o[3], vb, pa0, pa1, pa2, pa3);
}

__device__ __forceinline__ void attn_unit(const bf16_t* __restrict__ Q, const bf16_t* __restrict__ K, const bf16_t* __restrict__ V, const float* __restrict__ relb,
                                          bf16_t* __restrict__ mix, float* __restrict__ assq, int b, int h, int g, char* lds) {
    const int tid = threadIdx.x, wid = tid >> 6, lane = tid & 63, r32 = lane & 31, hi = lane >> 5;
    const int c0 = 4 * g, jp = wid >> 1;
    const size_t tokb = (size_t)b * SEQ;
    char* V_lds = lds; char* K_lds = lds + 2 * SHM_V;
    float* ws = (float*)(lds + OFF_WS) + wid * 64; float* li_l = ws; float* al_l = ws + 32;
    float* tbl = (float*)(lds + OFF_TBL);
    __syncthreads();
    for (int i = tid; i < 704; i += NTHREADS) { const int diff = i - 63; const int idx = (diff > 256 ? 256 : diff) + 256; tbl[i] = (i < 639) ? relb[h * NREL + idx] * LOG2E : -__builtin_inff(); }
    float m_reg = -1e30f, l_reg = 0.f; f32x16 o[4] = {};
    char* qr = lds + OFF_Q + wid * 8192 + lane * 16;
    const size_t qtok = tokb + (size_t)c0 * 64 + wid * 32;
    const bf16_t* Qw = Q + (qtok + r32) * LDK + h * HD + hi * 8;
#pragma unroll
    for (int d0 = 0; d0 < 8; ++d0) *reinterpret_cast<bf16x8*>(qr + d0 * 1024) = *reinterpret_cast<const bf16x8*>(Qw + d0 * 16);
    const int sr = tid >> 4, sc = (tid & 15) * 8, vst0 = v_st(sr, sc), vst1 = v_st(32 + sr, sc);
    const int vb0 = (int)(uintptr_t)V_lds + v_rd_base(lane);
    const bf16_t* Kh = K + tokb * LDK + h * HD + (size_t)sr * LDK + sc; const bf16_t* Vh = V + tokb * LDK + h * HD + (size_t)sr * LDK + sc;
    bf16x8 vs0, vs1, ks0, ks1;
#define KT(t) ((c0 - 8 + (t)) < 0 ? 0 : (c0 - 8 + (t)))
#define SLOAD(t) do { const size_t k0_ = (size_t)KT(t) * 64 * LDK; vs0 = *reinterpret_cast<const bf16x8*>(Vh + k0_); vs1 = *reinterpret_cast<const bf16x8*>(Vh + k0_ + 32 * LDK); \
    ks0 = *reinterpret_cast<const bf16x8*>(Kh + k0_); ks1 = *reinterpret_cast<const bf16x8*>(Kh + k0_ + 32 * LDK); } while (0)
#define SWRITE(t) do { const int bo_ = ((t) & 1) * SHM_V; *(bf16x8*)(V_lds + bo_ + vst0) = vs0; *(bf16x8*)(V_lds + bo_ + vst1) = vs1; const int kcB = sc * 2; \
    *(bf16x8*)(K_lds + bo_ + KSWZ(sr, kcB)) = ks0; *(bf16x8*)(K_lds + bo_ + KSWZ(32 + sr, kcB)) = ks1; } while (0)
#define RESC(a) do { if (__any((a) < 1.f)) { if (hi == 0) al_l[r32] = (a); asm volatile("s_waitcnt lgkmcnt(0)" ::: "memory"); \
    _Pragma("unroll") for (int d = 0; d < 4; ++d) _Pragma("unroll") for (int r = 0; r < 16; ++r) o[d][r] *= al_l[crow(r, hi)]; } } while (0)
#define TP(t) (((c0 - 8 + (t)) < 0) ? (tbl + 640) : (tbl + ((jp + 8 - (t)) * 64 + (wid & 1) * 32 + r32 + 4 - 4 * hi)))
#define KB(t) (K_lds + ((t) & 1) * SHM_K)
#define VB(t) (vb0 + ((t) & 1) * SHM_V)
#define ST_HEAD(t) do { if ((t) + 1 <= 11) SLOAD((t) + 1); } while (0)
#define ST_TAIL(t, resc) do { __syncthreads(); if ((t) + 1 <= 11) SWRITE((t) + 1); resc; __syncthreads(); } while (0)
    f32x16 pA0, pA1, pB0, pB1; float alA = 1.f, alB = 1.f; bf16x8 pa0, pa1, pa2, pa3;
    SLOAD(0); asm volatile("s_waitcnt vmcnt(0)" ::: "memory"); SWRITE(0); __syncthreads();
    int t = 0;
    for (; t < jp; ++t) { ST_HEAD(t); ST_TAIL(t, (void)0); }
    {
        SBAR(); qkt(pA0, pA1, KB(t), qr, r32, hi); ST_HEAD(t); SBAR();
        partialSM(pA0, pA1, m_reg, alA, TP(t));
        ST_TAIL(t, RESC(alA)); ++t;
    }
#pragma unroll 1
    for (int it = 0; it < 4; ++it) {
        {
            SBAR(); qkt(pB0, pB1, KB(t), qr, r32, hi);
            finishSM(pA0, pA1, alA, l_reg, pa0, pa1, pa2, pa3); SBAR();
            ST_HEAD(t); SBAR();
            pv_d0(o, VB(t - 1), pa0, pa1, pa2, pa3); partialSM(pB0, pB1, m_reg, alB, TP(t));
            ST_TAIL(t, RESC(alB)); ++t;
        }
        {
            SBAR(); qkt(pA0, pA1, KB(t), qr, r32, hi);
            finishSM(pB0, pB1, alB, l_reg, pa0, pa1, pa2, pa3); SBAR();
            ST_HEAD(t); SBAR();
            pv_d0(o, VB(t - 1), pa0, pa1, pa2, pa3); partialSM(pA0, pA1, m_reg, alA, TP(t));
            ST_TAIL(t, RESC(alA)); ++t;
        }
    }
    {
        finishSM(pA0, pA1, alA, l_reg, pa0, pa1, pa2, pa3); SBAR();
        if (t <= 11) ST_HEAD(t);
        SBAR(); pv_d0(o, VB(t - 1), pa0, pa1, pa2, pa3);
        if (t <= 11) { ST_TAIL(t, (void)0); }
        ++t;
    }
    for (; t <= 11; ++t) { ST_HEAD(t); ST_TAIL(t, (void)0); }
    if (hi == 0) li_l[r32] = l_reg;
    asm volatile("s_waitcnt lgkmcnt(0)" ::: "memory");
    int hi2 = hi; asm volatile("" : "+v"(hi2));
    bf16_t* Ow = mix + qtok * DM + h * HD + r32;
#pragma unroll
    for (int r = 0; r < 16; ++r) {
        const int orow = crow(r, hi2);
        const float rl = __builtin_amdgcn_rcpf(li_l[orow]);
        float s = 0.f;
#pragma unroll
        for (int d0 = 0; d0 < 4; ++d0) { const float v = o[d0][r] * rl; s += v * v; Ow[(size_t)orow * DM + d0 * 32] = (bf16_t)(cvtpk(v, 0.f) & 0xffffu); }
        s += __shfl_xor(s, 1); s += __shfl_xor(s, 2); s += __shfl_xor(s, 4); s += __shfl_xor(s, 8); s += __shfl_xor(s, 16);
        if (r32 == 0) assq[(qtok + orow) * 16 + h] = s;
    }
#undef KT
#undef SLOAD
#undef SWRITE
#undef RESC
#undef TP
#undef KB
#undef VB
#undef ST_HEAD
#undef ST_TAIL
}
}

namespace rec {
constexpr int XIN_OFF = 0, XIN_BYTES = 67 * 128 * 2;
constexpr int XRA_OFF = 17408, XRA_LD = 136;
constexpr int AL_OFF = 36864, UL_OFF = AL_OFF + 64 * 128 * 4, REC_LDS = UL_OFF + 64 * 128 * 4;
static_assert(XIN_BYTES <= XRA_OFF && XRA_OFF + 64 * XRA_LD * 2 <= AL_OFF, "rec LDS map");

__device__ __forceinline__ void rec_chain(const bf16_t* __restrict__ xrec, const bf16_t* __restrict__ gy, const float* __restrict__ conv_w, const float* __restrict__ conv_b,
                                          const bf16_t* __restrict__ wgt, const float* __restrict__ b_a, const float* __restrict__ b_x, const float* __restrict__ lam,
                                          bf16_t* __restrict__ mix, float* __restrict__ rssq, int b, int n, char* lds) {
    const int tid = threadIdx.x, wid = tid >> 6, lane = tid & 63, r32 = lane & 31, hi = lane >> 5, wr = wid >> 2, wc = wid & 3;
    bf16_t* xin = (bf16_t*)(lds + XIN_OFF); bf16_t* xra = (bf16_t*)(lds + XRA_OFF); float* aL = (float*)(lds + AL_OFF); float* uL = (float*)(lds + UL_OFF);
    const size_t tokb = (size_t)b * SEQ;
    const int cc = tid & 127, tq = tid >> 7, chg = n * RBD + cc;
    const float w0 = conv_w[0 * DREC + chg], w1 = conv_w[1 * DREC + chg], w2 = conv_w[2 * DREC + chg], w3 = conv_w[3 * DREC + chg], cb = conv_b[chg];
    const int cg = 32 * wc + r32, cgg = n * RBD + cg;
    const float ba = b_a[cgg], bx = b_x[cgg];
    const float sp8 = -8.0f * log1pf(expf(-lam[cgg])) * LOG2E;
    bf16x8 wa[8], wx[8];
#pragma unroll
    for (int s = 0; s < 8; ++s) {
        wa[s] = *reinterpret_cast<const bf16x8*>(wgt + ((size_t)(n * 2 + 0) * 128 + cg) * 128 + 16 * s + 8 * hi);
        wx[s] = *reinterpret_cast<const bf16x8*>(wgt + ((size_t)(n * 2 + 1) * 128 + cg) * 128 + 16 * s + 8 * hi);
    }
    __syncthreads();
    if (tid < 384) xin[tid] = 0;
    float hcar = 0.f;
    const int lrow = tid >> 3, lcol = (tid & 7) * 16;
    for (int tile = 0; tile < SEQ / 64; ++tile) {
        const size_t t0 = tokb + (size_t)tile * 64;
        {
            const bf16_t* src = xrec + (t0 + lrow) * 2048 + n * RBD + lcol;
            const u32x4 v0 = *reinterpret_cast<const u32x4*>(src), v1 = *reinterpret_cast<const u32x4*>(src + 8);
            *reinterpret_cast<u32x4*>(xin + (3 + lrow) * 128 + lcol) = v0; *reinterpret_cast<u32x4*>(xin + (3 + lrow) * 128 + lcol + 8) = v1;
        }
        __syncthreads();
        {
            float x0 = bf2f(xin[(16 * tq + 0) * 128 + cc]), x1 = bf2f(xin[(16 * tq + 1) * 128 + cc]), x2 = bf2f(xin[(16 * tq + 2) * 128 + cc]);
#pragma unroll
            for (int tt = 0; tt < 16; ++tt) {
                const float x3 = bf2f(xin[(16 * tq + tt + 3) * 128 + cc]);
                const float v = cb + w0 * x0 + w1 * x1 + w2 * x2 + w3 * x3;
                xra[(16 * tq + tt) * XRA_LD + cc] = (bf16_t)(cvtpk(v, 0.f) & 0xffffu);
                x0 = x1; x1 = x2; x2 = x3;
            }
        }
        __syncthreads();
        if (tid < 384) xin[tid] = xin[64 * 128 + tid];
        {
            f32x16 ga = {}, gx = {};
#pragma unroll
            for (int s = 0; s < 8; ++s) {
                const bf16x8 af = *reinterpret_cast<const bf16x8*>(xra + (32 * wr + r32) * XRA_LD + 16 * s + 8 * hi);
                ga = __builtin_amdgcn_mfma_f32_32x32x16_bf16(af, wa[s], ga, 0, 0, 0);
                gx = __builtin_amdgcn_mfma_f32_32x32x16_bf16(af, wx[s], gx, 0, 0, 0);
            }
#pragma unroll
            for (int r = 0; r < 16; ++r) {
                const int t = 32 * wr + att::crow(r, hi);
                const float xv = bf2f(xra[t * XRA_LD + cg]);
                const float rg = sigmoid_f(ga[r] + ba), ig = sigmoid_f(gx[r] + bx);
                const float l2a = sp8 * rg;
                const float av = __builtin_amdgcn_exp2f(l2a);
                const float xx = 2.0f * 0.6931471805599453f * l2a;
                const float poly = -xx * (1.0f + xx * (0.5f + xx * (0.16666667f + xx * (0.041666668f + xx * (0.008333334f + xx * 0.0013888889f)))));
                const float om = (xx > -0.3f) ? poly : (1.0f - av * av);
                const float mult = __builtin_amdgcn_sqrtf(om);
                aL[t * 128 + cg] = av; uL[t * 128 + cg] = mult * ig * xv;
            }
        }
        __syncthreads();
        if (tid < 128) {
#pragma unroll 8
            for (int t = 0; t < 64; ++t) { hcar = fmaf(aL[t * 128 + tid], hcar, uL[t * 128 + tid]); uL[t * 128 + tid] = hcar; }
        }
        __syncthreads();
        {
            const bf16_t* gsrc = gy + (t0 + lrow) * 2048 + n * RBD + lcol;
            const u32x4 g0 = *reinterpret_cast<const u32x4*>(gsrc), g1 = *reinterpret_cast<const u32x4*>(gsrc + 8);
            const float* hp = uL + lrow * 128 + lcol;
            float ss = 0.f; u32x4 o0, o1;
#pragma unroll
            for (int j = 0; j < 4; ++j) { const float a0 = hp[2 * j] * bf_lo(g0[j]), a1 = hp[2 * j + 1] * bf_hi(g0[j]); ss += a0 * a0 + a1 * a1; o0[j] = cvtpk(a0, a1); }
#pragma unroll
            for (int j = 0; j < 4; ++j) { const float a0 = hp[8 + 2 * j] * bf_lo(g1[j]), a1 = hp[8 + 2 * j + 1] * bf_hi(g1[j]); ss += a0 * a0 + a1 * a1; o1[j] = cvtpk(a0, a1); }
            bf16_t* dst = mix + (t0 + lrow) * DM + DATT + n * RBD + lcol;
            *reinterpret_cast<u32x4*>(dst) = o0; *reinterpret_cast<u32x4*>(dst + 8) = o1;
            ss += __shfl_xor(ss, 1); ss += __shfl_xor(ss, 2); ss += __shfl_xor(ss, 4);
            if ((tid & 7) == 0) rssq[(t0 + lrow) * 16 + n] = ss;
        }
        __syncthreads();
    }
}
}

struct Args {
    const float* in[22]; float* out; unsigned char* ws; int ph_lo, ph_hi;
};
__device__ __forceinline__ void transpose_tile(const float* __restrict__ src, bf16_t* __restrict__ dst, const float* __restrict__ gain, int K, int N, int k0, int n0, float* tile, int tid) {
    const int r = tid >> 4, c4 = (tid & 15) * 4;
#pragma unroll
    for (int p = 0; p < 2; ++p) {
        const int k = k0 + r + 32 * p;
        const f32x4 v = *reinterpret_cast<const f32x4*>(src + (size_t)k * N + n0 + c4);
        const float g = gain ? gain[k] : 1.0f;
        float* tp = tile + (r + 32 * p) * 65 + c4;
        tp[0] = v[0] * g; tp[1] = v[1] * g; tp[2] = v[2] * g; tp[3] = v[3] * g;
    }
    __syncthreads();
    const int nn = tid >> 3, k8 = (tid & 7) * 8;
    const float* cp = tile + k8 * 65 + nn;
    u32x4 o; o.x = cvtpk(cp[0], cp[65]); o.y = cvtpk(cp[130], cp[195]); o.z = cvtpk(cp[260], cp[325]); o.w = cvtpk(cp[390], cp[455]);
    *reinterpret_cast<u32x4*>(dst + (size_t)(n0 + nn) * K + k0 + k8) = o;
    __syncthreads();
}
__device__ __forceinline__ void p0_prologue(const Args& a, char* lds) {
    const int tid = threadIdx.x, lane = tid & 63, wid = tid >> 6, G = gridDim.x, bid = blockIdx.x;
    unsigned char* ws = a.ws; unsigned char* sm = ws + WS_SMALL;
    {
        const float* x = a.in[0]; bf16_t* xb = (bf16_t*)(ws + WS_XB); float* rstd1 = (float*)(sm + SM_RSTD1);
        for (int row = bid * NWAVES + wid; row < TOK; row += G * NWAVES) {
            const f32x4* src = reinterpret_cast<const f32x4*>(x + (size_t)row * DM);
            u32x4* dst = reinterpret_cast<u32x4*>(xb + (size_t)row * DM);
            float ss = 0.f;
#pragma unroll
            for (int i = 0; i < 8; ++i) {
                const f32x4 p = src[2 * (lane + 64 * i)], q = src[2 * (lane + 64 * i) + 1];
                ss += (p[0] * p[0] + p[1] * p[1]) + (p[2] * p[2] + p[3] * p[3]) + (q[0] * q[0] + q[1] * q[1]) + (q[2] * q[2] + q[3] * q[3]);
                u32x4 o; o.x = cvtpk(p[0], p[1]); o.y = cvtpk(p[2], p[3]); o.z = cvtpk(q[0], q[1]); o.w = cvtpk(q[2], q[3]);
                dst[lane + 64 * i] = o;
            }
            ss = wave_sum(ss);
            if (lane == 0) rstd1[row] = __builtin_amdgcn_rsqf(ss * (1.0f / DM) + EPS);
        }
    }
    {
        float* tile = (float*)lds;
        const int n_in = (DM / 64) * (NIN / 64), n_out = (DM / 64) * (DM / 64), n_pq = (DM / 64) * (PQN / 64), n_g = 16 * 2 * 4;
        for (int t = bid; t < n_in + n_out + n_pq + n_g; t += G) {
            if (t < n_in) { const int kt = t / (NIN / 64), nt = t % (NIN / 64); transpose_tile(a.in[2], (bf16_t*)(ws + WS_WIN), a.in[1], DM, NIN, kt * 64, nt * 64, tile, tid); }
            else if (t < n_in + n_out) { const int u = t - n_in, kt = u / (DM / 64), nt = u % (DM / 64); transpose_tile(a.in[15], (bf16_t*)(ws + WS_WOUT), nullptr, DM, DM, kt * 64, nt * 64, tile, tid); }
            else if (t < n_in + n_out + n_pq) { const int u = t - n_in - n_out, kt = u / (PQN / 64), nt = u % (PQN / 64); transpose_tile(a.in[17], (bf16_t*)(ws + WS_WPQ), a.in[16], DM, PQN, kt * 64, nt * 64, tile, tid); }
            else { const int u = t - n_in - n_out - n_pq, blk = u >> 3, gate = (u >> 2) & 1, q4 = u & 3, kt = q4 >> 1, nt = q4 & 1;
                   transpose_tile(a.in[gate ? 10 : 8] + (size_t)blk * 128 * 128, (bf16_t*)(sm + SM_WGT) + (size_t)(blk * 2 + gate) * 128 * 128, nullptr, 128, 128, kt * 64, nt * 64, tile, tid); }
        }
    }
    {
        const size_t gt = (size_t)bid * NTHREADS + tid, nth = (size_t)G * NTHREADS;
        const f32x4* us = reinterpret_cast<const f32x4*>(a.in[20]); const f32x4* vs = reinterpret_cast<const f32x4*>(a.in[21]); const f32x4* g2 = reinterpret_cast<const f32x4*>(a.in[16]);
        u32x4* ub = reinterpret_cast<u32x4*>(ws + WS_UB); u32x4* vb = reinterpret_cast<u32x4*>(ws + WS_VB);
        const size_t n8 = (size_t)NEXP * DM / 8;
        for (size_t i = gt; i < n8; i += nth) {
            const f32x4 p = us[2 * i], q = us[2 * i + 1]; const int c8 = (int)(i & (DM / 8 - 1));
            const f32x4 ga = g2[2 * c8], gb = g2[2 * c8 + 1];
            u32x4 o; o.x = cvtpk(p[0] * ga[0], p[1] * ga[1]); o.y = cvtpk(p[2] * ga[2], p[3] * ga[3]); o.z = cvtpk(q[0] * gb[0], q[1] * gb[1]); o.w = cvtpk(q[2] * gb[2], q[3] * gb[3]);
            ub[i] = o;
        }
        for (size_t i = gt; i < n8; i += nth) {
            const f32x4 p = vs[2 * i], q = vs[2 * i + 1];
            u32x4 o; o.x = cvtpk(p[0], p[1]); o.y = cvtpk(p[2], p[3]); o.z = cvtpk(q[0], q[1]); o.w = cvtpk(q[2], q[3]);
            vb[i] = o;
        }
        const size_t nk8 = (size_t)PH * PNK * 128 / 8;
        u32x4* kb = reinterpret_cast<u32x4*>(sm + SM_KEYS);
        for (size_t i = gt; i < 2 * nk8; i += nth) {
            const f32x4* ks = reinterpret_cast<const f32x4*>(i < nk8 ? a.in[18] : a.in[19]); const size_t j = i < nk8 ? i : i - nk8;
            const f32x4 p = ks[2 * j], q = ks[2 * j + 1];
            u32x4 o; o.x = cvtpk(p[0], p[1]); o.y = cvtpk(p[2], p[3]); o.z = cvtpk(q[0], q[1]); o.w = cvtpk(q[2], q[3]);
            kb[i] = o;
        }
    }
}

__device__ __forceinline__ void p3_mixnorm(const Args& a) {
    const int tid = threadIdx.x, lane = tid & 63, wid = tid >> 6, G = gridDim.x, bid = blockIdx.x;
    unsigned char* sm = a.ws + WS_SMALL;
    bf16_t* mix = (bf16_t*)(a.ws + WS_MIX); const float* assq = (const float*)(sm + SM_ASSQ); const float* rssq = (const float*)(sm + SM_RSSQ);
    const float* ga = a.in[13]; const float* gr = a.in[14];
    for (int row = bid * NWAVES + wid; row < TOK; row += G * NWAVES) {
        float sa = (lane < 16) ? assq[(size_t)row * 16 + lane] : 0.f, sr = (lane < 16) ? rssq[(size_t)row * 16 + lane] : 0.f;
        sa = wave_sum(sa); sr = wave_sum(sr);
        const float ra = __builtin_amdgcn_rsqf(sa * (1.0f / DATT) + EPS), rr = __builtin_amdgcn_rsqf(sr * (1.0f / DREC) + EPS);
        u32x4* p = reinterpret_cast<u32x4*>(mix + (size_t)row * DM);
#pragma unroll
        for (int i = 0; i < 8; ++i) {
            const int idx = lane + 64 * i;
            const bool isr = i >= 4; const float rs = isr ? rr : ra;
            const float* g = isr ? (gr + 8 * (idx - 256)) : (ga + 8 * idx);
            const f32x4 g0 = *reinterpret_cast<const f32x4*>(g), g1 = *reinterpret_cast<const f32x4*>(g + 4);
            const u32x4 v = p[idx]; u32x4 o;
            o.x = cvtpk(bf_lo(v.x) * rs * g0[0], bf_hi(v.x) * rs * g0[1]); o.y = cvtpk(bf_lo(v.y) * rs * g0[2], bf_hi(v.y) * rs * g0[3]);
            o.z = cvtpk(bf_lo(v.z) * rs * g1[0], bf_hi(v.z) * rs * g1[1]); o.w = cvtpk(bf_lo(v.w) * rs * g1[2], bf_hi(v.w) * rs * g1[3]);
            p[idx] = o;
        }
    }
}

namespace peer {
constexpr int SEL_E = 0, SEL_G = 64 * 128 * 4, SCR = 2 * 64 * 128 * 4, R2 = SCR + NWAVES * 32 * 32 * 4, WBUF = R2 + 64 * 4, ABUF = WBUF + NWAVES * 128 * 4, PEER_LDS = ABUF + NWAVES * 128 * 4;
static_assert(PEER_LDS <= LDS_MISC, "peer LDS map");
constexpr float NEG = -3.0e38f;

__device__ __forceinline__ void ins16(float (&t)[16], float x) {
#pragma unroll
    for (int i = 0; i < 16; ++i) { const float hi = fmaxf(t[i], x); x = fminf(t[i], x); t[i] = hi; }
}
__device__ __forceinline__ void merge_partner(float (&t)[16]) {
    float m[16];
#pragma unroll
    for (int i = 0; i < 16; ++i) { const float p = __shfl_xor(t[15 - i], 32); m[i] = fmaxf(t[i], p); }
#define CE_STAGE(d) _Pragma("unroll") for (int i = 0; i < 16; ++i) if ((i & (d)) == 0) { const float hi = fmaxf(m[i], m[i + (d)]), lo = fminf(m[i], m[i + (d)]); m[i] = hi; m[i + (d)] = lo; }
    CE_STAGE(8) CE_STAGE(4) CE_STAGE(2) CE_STAGE(1)
#undef CE_STAGE
#pragma unroll
    for (int i = 0; i < 16; ++i) t[i] = m[i];
}
__device__ __forceinline__ void side_topk(const bf16_t* __restrict__ qb, const bf16_t* __restrict__ kb, float rs, int r32, int hi, float (&t)[16]) {
    bf16x8 qf[8];
#pragma unroll
    for (int s = 0; s < 8; ++s) qf[s] = *reinterpret_cast<const bf16x8*>(qb + 16 * s);
#pragma unroll
    for (int i = 0; i < 16; ++i) t[i] = NEG;
#pragma unroll
    for (int nb = 0; nb < 4; ++nb) {
        f32x16 acc = {};
        const bf16_t* kr = kb + (size_t)(32 * nb + r32) * 128 + 8 * hi;
#pragma unroll
        for (int s = 0; s < 8; ++s) { const bf16x8 kf = *reinterpret_cast<const bf16x8*>(kr + 16 * s); acc = __builtin_amdgcn_mfma_f32_32x32x16_bf16(kf, qf[s], acc, 0, 0, 0); }
#pragma unroll
        for (int r = 0; r < 16; ++r) {
            const unsigned n = 32 * nb + att::crow(r, hi);
            ins16(t, __uint_as_float((__float_as_uint(acc[r] * rs) & ~127u) | n));
        }
    }
    merge_partner(t);
}

__device__ __forceinline__ void peer_unit(const Args& a, int unit, char* lds) {
    const int tid = threadIdx.x, wid = tid >> 6, lane = tid & 63, r32 = lane & 31, hi = lane >> 5;
    unsigned char* sm = a.ws + WS_SMALL;
    const bf16_t* pq = (const bf16_t*)(a.ws + WS_Q); const bf16_t* keys = (const bf16_t*)(sm + SM_KEYS); const float* ssq2 = (const float*)(sm + SM_SSQ2);
    const bf16_t* x2b = (const bf16_t*)(a.ws + WS_XB); const bf16_t* ub = (const bf16_t*)(a.ws + WS_UB); const bf16_t* vb = (const bf16_t*)(a.ws + WS_VB);
    int* sel_e = (int*)(lds + SEL_E); float* sel_g = (float*)(lds + SEL_G); float* scr = (float*)(lds + SCR) + wid * 1024; float* r2 = (float*)(lds + R2);
    float* wbuf = (float*)(lds + WBUF) + wid * 128; float* abuf = (float*)(lds + ABUF) + wid * 128;
    const size_t tok0 = (size_t)unit * 64;
    __syncthreads();
#pragma unroll
    for (int j = 0; j < 8; ++j) {
        const int tl = wid * 8 + j; float s = ssq2[(tok0 + tl) * 64 + lane]; s = wave_sum(s);
        if (lane == 0) r2[tl] = __builtin_amdgcn_rsqf(s * (1.0f / DM) + EPS);
    }
    __syncthreads();
#pragma unroll 1
    for (int task = wid; task < 16; task += NWAVES) {
        const int tg = task & 1, hh = task >> 1, tl = 32 * tg + r32;
        const float rs = r2[tl];
        const bf16_t* qrow = pq + (tok0 + tl) * PQN + hh * PQD + 8 * hi;
        float t1[16], t2[16];
        side_topk(qrow, keys + (size_t)(0 * PH + hh) * PNK * 128, rs, r32, hi, t1);
        side_topk(qrow + 128, keys + (size_t)(1 * PH + hh) * PNK * 128, rs, r32, hi, t2);
        if (hi == 0) {
#pragma unroll
            for (int j = 0; j < 16; ++j) { scr[j * 32 + r32] = t1[j]; scr[(16 + j) * 32 + r32] = t2[j]; }
        }
        float c[16];
#pragma unroll
        for (int i = 0; i < 16; ++i) c[i] = NEG;
#pragma unroll
        for (int ia = 0; ia < 16; ++ia)
#pragma unroll
            for (int ib = 0; ib < 16; ++ib)
                if ((ia + 1) * (ib + 1) <= 16) ins16(c, __uint_as_float((__float_as_uint(t1[ia] + t2[ib]) & ~255u) | (unsigned)(ia * 16 + ib)));
        asm volatile("s_waitcnt lgkmcnt(0)" ::: "memory");
        float ev[8]; int ee[8]; float esum = 0.f;
        unsigned hmsk = hi ? 0xffffffffu : 0u; asm volatile("" : "+v"(hmsk));
        const float cmax = __uint_as_float(__float_as_uint(c[0]) & ~255u);
#pragma unroll
        for (int k = 0; k < 8; ++k) {
            const unsigned code = ((__float_as_uint(c[8 + k]) & hmsk) | (__float_as_uint(c[k]) & ~hmsk)) & 255u;
            const unsigned p1 = __float_as_uint(scr[(code >> 4) * 32 + r32]), p2 = __float_as_uint(scr[(16 + (code & 15u)) * 32 + r32]);
            const float v = __uint_as_float(p1 & ~127u) + __uint_as_float(p2 & ~127u);
            ee[k] = (int)((p1 & 127u) * PNK + (p2 & 127u));
            ev[k] = __builtin_amdgcn_exp2f((v - cmax) * LOG2E); esum += ev[k];
        }
        esum += __shfl_xor(esum, 32);
        const float inv = __builtin_amdgcn_rcpf(esum);
#pragma unroll
        for (int k = 0; k < 8; ++k) { sel_e[tl * 128 + hh * 16 + 8 * hi + k] = ee[k]; sel_g[tl * 128 + hh * 16 + 8 * hi + k] = ev[k] * inv; }
    }
    __syncthreads();
#pragma unroll 1
    for (int tl = wid; tl < 64; tl += NWAVES) {
        const size_t tok = tok0 + tl;
        const float rs = r2[tl];
        u32x4 hx[8];
#pragma unroll
        for (int i = 0; i < 8; ++i) hx[i] = *reinterpret_cast<const u32x4*>(x2b + tok * DM + i * 512 + lane * 8);
#pragma unroll 1
        for (int k0 = 0; k0 < 128; k0 += 4) {
            float part[4];
#pragma unroll
            for (int j = 0; j < 4; ++j) {
                const int e = __builtin_amdgcn_readfirstlane(sel_e[tl * 128 + k0 + j]);
                const bf16_t* up = ub + (size_t)e * DM + lane * 8;
                float s = 0.f;
#pragma unroll
                for (int i = 0; i < 8; ++i) {
                    const u32x4 w = *reinterpret_cast<const u32x4*>(up + i * 512);
                    s = dot2bf(w.x, hx[i].x, s); s = dot2bf(w.y, hx[i].y, s); s = dot2bf(w.z, hx[i].z, s); s = dot2bf(w.w, hx[i].w, s);
                }
                part[j] = s;
            }
#pragma unroll
            for (int j = 0; j < 4; ++j) part[j] = wave_sum(part[j]);
            if (lane == 0) { abuf[k0] = part[0]; abuf[k0 + 1] = part[1]; abuf[k0 + 2] = part[2]; abuf[k0 + 3] = part[3]; }
        }
        asm volatile("s_waitcnt lgkmcnt(0)" ::: "memory");
        {
            const float a0 = abuf[lane] * rs, a1 = abuf[64 + lane] * rs;
            wbuf[lane] = sel_g[tl * 128 + lane] * gelu_tanh(a0); wbuf[64 + lane] = sel_g[tl * 128 + 64 + lane] * gelu_tanh(a1);
        }
        asm volatile("s_waitcnt lgkmcnt(0)" ::: "memory");
        float y[64];
#pragma unroll
        for (int i = 0; i < 64; ++i) y[i] = 0.f;
#pragma unroll 1
        for (int k0 = 0; k0 < 128; k0 += 2) {
#pragma unroll
            for (int j = 0; j < 2; ++j) {
                const int e = __builtin_amdgcn_readfirstlane(sel_e[tl * 128 + k0 + j]);
                const float wk = wbuf[k0 + j];
                const bf16_t* vp = vb + (size_t)e * DM + lane * 8;
#pragma unroll
                for (int i = 0; i < 8; ++i) {
                    const u32x4 w = *reinterpret_cast<const u32x4*>(vp + i * 512);
                    y[8 * i + 0] = fmaf(wk, bf_lo(w.x), y[8 * i + 0]); y[8 * i + 1] = fmaf(wk, bf_hi(w.x), y[8 * i + 1]);
                    y[8 * i + 2] = fmaf(wk, bf_lo(w.y), y[8 * i + 2]); y[8 * i + 3] = fmaf(wk, bf_hi(w.y), y[8 * i + 3]);
                    y[8 * i + 4] = fmaf(wk, bf_lo(w.z), y[8 * i + 4]); y[8 * i + 5] = fmaf(wk, bf_hi(w.z), y[8 * i + 5]);
                    y[8 * i + 6] = fmaf(wk, bf_lo(w.w), y[8 * i + 6]); y[8 * i + 7] = fmaf(wk, bf_hi(w.w), y[8 * i + 7]);
                }
            }
        }
        float* op = a.out + tok * DM + lane * 8;
#pragma unroll
        for (int i = 0; i < 8; ++i) {
            f32x4 p = *reinterpret_cast<const f32x4*>(op + i * 512), q = *reinterpret_cast<const f32x4*>(op + i * 512 + 4);
            p[0] += y[8 * i + 0]; p[1] += y[8 * i + 1]; p[2] += y[8 * i + 2]; p[3] += y[8 * i + 3];
            q[0] += y[8 * i + 4]; q[1] += y[8 * i + 5]; q[2] += y[8 * i + 6]; q[3] += y[8 * i + 7];
            *reinterpret_cast<f32x4*>(op + i * 512) = p; *reinterpret_cast<f32x4*>(op + i * 512 + 4) = q;
        }
    }
}
}

constexpr int N_PHASES = 7;
#ifndef MK_N_LAUNCHES
#define MK_N_LAUNCHES 1
#endif
__global__ void __launch_bounds__(NTHREADS, 2) mk_fwd(Args args) {
    extern __shared__ __attribute__((aligned(16))) unsigned char lds[];
    const int tid = threadIdx.x;
    unsigned char* ws = args.ws; unsigned char* sm = ws + WS_SMALL;
    unsigned* ctl = (unsigned*)(ws + WS_CTL);
    volatile LAS unsigned* misc = (volatile LAS unsigned*)((LAS unsigned char*)lds + LDS_MISC);
    if (tid < 16) misc[tid] = 0u;
    __syncthreads();
    const int lo = args.ph_lo, hi = args.ph_hi;
    const bool multi = (hi - lo) > 1;
    XcdBarrier bar; bar.bar = ctl + CW_BAR; bar.x = 0; bar.st = misc;
    if (multi) bar = xcd_barrier_post(ctl + CW_BAR, misc);
#ifndef PH_MASK
#define PH_MASK 0x7f
#endif
#define IN(k) (((PH_MASK >> (k)) & 1) && lo <= (k) && (k) < hi)
#define SEAM(k) do { if (IN(k) && IN((k) + 1)) xcd_barrier(bar); } while (0)

    if (IN(0)) { p0_prologue(args, (char*)lds); SEAM(0); }

    if (IN(1)) {
        pg8::Gemm g{(const bf16_t*)(ws + WS_XB), (const bf16_t*)(ws + WS_WIN), TOK, NIN, DM};
        pg8::StaticOrder S; S.init(TOK, NIN, (int)gridDim.x, (int)blockIdx.x);
        pg8::EpiProj E{(bf16_t*)(ws + WS_Q), (size_t)(WS_K - WS_Q) / 2, (const float*)(sm + SM_RSTD1), args.in[3], args.in[4], (LAS float*)((LAS unsigned char*)lds + LDS_XCH)};
        pg8::gemm_phase<pg8::EpiProj, pg8::StaticOrder, false>((LAS unsigned char*)lds, g, S, E, nullptr);
        SEAM(1);
    }

    if (IN(2)) {
#ifndef NO_REC
        for (;;) {
            __syncthreads();
            if (tid == 0) misc[4] = __hip_atomic_fetch_add(ctl + CW_QUEUE, 1u, RLX_AGENT);
            __syncthreads();
            const int item = (int)misc[4];
            if (item >= 64) break;
            rec::rec_chain((const bf16_t*)(ws + WS_XR), (const bf16_t*)(ws + WS_GY), args.in[6], args.in[7], (const bf16_t*)(sm + SM_WGT), args.in[9], args.in[11], args.in[12],
                           (bf16_t*)(ws + WS_MIX), (float*)(sm + SM_RSSQ), item >> 4, item & 15, (char*)lds);
        }
#endif
#ifndef NO_ATT
        for (;;) {
            __syncthreads();
            if (tid == 0) misc[4] = __hip_atomic_fetch_add(ctl + CW_QUEUE + 64, 1u, RLX_AGENT);
            __syncthreads();
            const int u = (int)misc[4];
            if (u >= 1024) break;
            const int g = 15 - (u >> 6), bh = u & 63;
            att::attn_unit((const bf16_t*)(ws + WS_Q), (const bf16_t*)(ws + WS_K), (const bf16_t*)(ws + WS_V), args.in[5], (bf16_t*)(ws + WS_MIX), (float*)(sm + SM_ASSQ), bh >> 4, bh & 15, g, (char*)lds);
        }
#endif
        SEAM(2);
    }

    if (IN(3)) { p3_mixnorm(args); SEAM(3); }

    if (IN(4)) {
        pg8::Gemm g{(const bf16_t*)(ws + WS_MIX), (const bf16_t*)(ws + WS_WOUT), TOK, DM, DM};
        pg8::StaticOrder S; S.init(TOK, DM, (int)gridDim.x, (int)blockIdx.x);
        pg8::EpiOut E{args.in[0], args.out, (bf16_t*)(ws + WS_XB), (float*)(sm + SM_SSQ2)};
        pg8::gemm_phase<pg8::EpiOut, pg8::StaticOrder, false>((LAS unsigned char*)lds, g, S, E, nullptr);
        SEAM(4);
    }

    if (IN(5)) {
        pg8::Gemm g{(const bf16_t*)(ws + WS_XB), (const bf16_t*)(ws + WS_WPQ), TOK, PQN, DM};
        pg8::StaticOrder S; S.init(TOK, PQN, (int)gridDim.x, (int)blockIdx.x);
        pg8::EpiPq E{(bf16_t*)(ws + WS_Q)};
        pg8::gemm_phase<pg8::EpiPq, pg8::StaticOrder, false>((LAS unsigned char*)lds, g, S, E, nullptr);
        SEAM(5);
    }

    if (IN(6)) {
        for (int u = blockIdx.x; u < TOK / 64; u += gridDim.x) peer::peer_unit(args, u, (char*)lds);
    }
#undef IN
#undef SEAM
}

extern "C" void kernel_launch(void* const* d_in, const int* in_sizes, int n_in, void* d_out, int out_size, void* d_ws, size_t ws_size, hipStream_t stream) {
    static int grid = 0;
    if (grid == 0) {
        if (n_in != 22 || in_sizes[0] != TOK * DM || out_size != TOK * DM || ws_size < WS_END) {
            fprintf(stderr, "kernel_launch: built for 22 inputs, x/out of %d floats, >= %zu bytes of workspace; got n_in %d, in0 %d, out %d, ws %zu; nothing launched\n", TOK * DM, (size_t)WS_END, n_in, n_in > 0 ? in_sizes[0] : -1, out_size, ws_size);
            grid = -1; return; }
        int dev = 0, cus = 0, per_cu = 0;
        if (hipGetDevice(&dev) != hipSuccess || hipDeviceGetAttribute(&cus, hipDeviceAttributeMultiprocessorCount, dev) != hipSuccess) { fprintf(stderr, "kernel_launch: device query failed\n"); grid = -1; return; }
        if (hipFuncSetAttribute((const void*)mk_fwd, hipFuncAttributeMaxDynamicSharedMemorySize, LDS_BYTES) != hipSuccess) { fprintf(stderr, "kernel_launch: hipFuncSetAttribute failed\n"); grid = -1; return; }
        if (hipOccupancyMaxActiveBlocksPerMultiprocessor(&per_cu, (const void*)mk_fwd, NTHREADS, LDS_BYTES) != hipSuccess || per_cu < 1)
            fprintf(stderr, "kernel_launch: note: occupancy query reports %d workgroups per CU\n", per_cu);
        (void)hipGetLastError();
        grid = cus;
    }
    if (grid < 0) return;
    if (hipMemsetAsync((char*)d_ws + WS_CTL, 0, CTL_BYTES, stream) != hipSuccess) { fprintf(stderr, "kernel_launch: memset failed\n"); return; }
    Args a{};
    for (int i = 0; i < 22; ++i) a.in[i] = (const float*)d_in[i];
    a.out = (float*)d_out; a.ws = (unsigned char*)d_ws;
#if MK_N_LAUNCHES == 1
    a.ph_lo = 0; a.ph_hi = N_PHASES;
    hipLaunchKernelGGL(mk_fwd, dim3(grid), dim3(NTHREADS), LDS_BYTES, stream, a);
#else
    for (int p = 0; p < N_PHASES; ++p) { a.ph_lo = p; a.ph_hi = p + 1; hipLaunchKernelGGL(mk_fwd, dim3(grid), dim3(NTHREADS), LDS_BYTES, stream, a); }
#endif
    const hipError_t le = hipPeekAtLastError();
    if (le != hipSuccess) fprintf(stderr, "kernel_launch: launch failed: %s\n", hipGetErrorName(le));
}
```

```cpp
#include <hip/hip_runtime.h>
#include <cstdio>
#include <cstdint>

#define LAS __attribute__((address_space(3)))
#define RLX_AGENT __ATOMIC_RELAXED, __HIP_MEMORY_SCOPE_AGENT

constexpr int BATCH = 4, SEQ = 4096, TOK = BATCH * SEQ, DM = 4096, DATT = 2048, DREC = 2048, NIN = 10240, NHEAD = 16, HD = 128, CHUNK = 64, NREL = 513;
constexpr int NRB = 16, RBD = 128, PH = 8, PNK = 128, PQD = 256, PTOPK = 16, PQN = PH * PQD  , NEXP = 16384;
constexpr float EPS = 1e-6f, LOG2E = 1.4426950408889634f;

constexpr size_t MB = 1024ull * 1024ull;
constexpr size_t WS_CTL = 0;
constexpr size_t CTL_BYTES = 64 * 1024;
constexpr size_t WS_PROG = WS_CTL + CTL_BYTES;
constexpr size_t PROG_BYTES = 16 * 256 * 4;
constexpr size_t WS_SMALL = WS_PROG + 64 * 1024;
constexpr size_t SM_RSTD1 = 0;
constexpr size_t SM_ASSQ = SM_RSTD1 + (size_t)TOK * 4;
constexpr size_t SM_RSSQ = SM_ASSQ + (size_t)TOK * 16 * 4;
constexpr size_t SM_SSQ2 = SM_RSSQ + (size_t)TOK * 16 * 4;
constexpr size_t SM_WGT = SM_SSQ2 + (size_t)TOK * 64 * 4;
constexpr size_t SM_KEYS = SM_WGT + (size_t)16 * 2 * 128 * 128 * 2;
constexpr size_t SM_SU = SM_KEYS + (size_t)2 * 8 * 128 * 128 * 2;
constexpr size_t SM_SV = SM_SU + (size_t)16384 * 4;
constexpr size_t SM_RSUM = SM_SV + (size_t)16384 * 4;
constexpr size_t SM_END = SM_RSUM + (size_t)16384 * 4;
constexpr size_t WS_XB = WS_SMALL + 8 * MB;
constexpr size_t WS_WIN = WS_XB + 128 * MB;
constexpr size_t WS_WOUT = WS_WIN + 80 * MB;
constexpr size_t WS_WPQ = WS_WOUT + 32 * MB;
constexpr size_t WS_UB = WS_WPQ + 16 * MB;
constexpr size_t WS_VB = WS_UB + 128 * MB;
constexpr size_t WS_Q = WS_VB + 128 * MB;
constexpr size_t WS_K = WS_Q + 64 * MB;
constexpr size_t WS_V = WS_K + 64 * MB;
constexpr size_t WS_XR = WS_V + 64 * MB;
constexpr size_t WS_GY = WS_XR + 64 * MB;
constexpr size_t WS_MIX = WS_GY + 64 * MB;
constexpr size_t WS_END = WS_MIX + 128 * MB;
static_assert(SM_END <= 8 * MB, "small region");

constexpr int CW_BAR = 0;
constexpr int CW_QUEUE = 4096;
constexpr int CW_TMO = 4160;
constexpr int CW_XCNT = 4224;

constexpr int NWAVES = 8, NTHREADS = 512;
constexpr int LDS_BYTES = 147456;
constexpr int LDS_XCH = 131072;
constexpr int LDS_MISC = 143360;

typedef unsigned short bf16_t;
typedef short bf16x8 __attribute__((ext_vector_type(8)));
typedef short s16x4 __attribute__((ext_vector_type(4)));
typedef float f32x4 __attribute__((ext_vector_type(4)));
typedef float f32x16 __attribute__((ext_vector_type(16)));
typedef unsigned u32x4 __attribute__((ext_vector_type(4)));
typedef __attribute__((ext_vector_type(2))) __bf16 bf16x2_t;
typedef unsigned u32x6 __attribute__((ext_vector_type(6)));
typedef unsigned u32x16 __attribute__((ext_vector_type(16)));
typedef float f32x32 __attribute__((ext_vector_type(32)));
constexpr int V4ROW = 2048;
constexpr int V6ROW = 3072;
#ifndef FP6_INTERLEAVED
#define FP6_INTERLEAVED 1
#endif
__host__ __device__ constexpr int fp6_feat(int j) { return FP6_INTERLEAVED ? ((j >> 1) + 16 * (j & 1)) : j; }

constexpr float W8S = 64.0f, MIX_SA = 16.0f, MIX_SR = 4.0f;
__device__ __forceinline__ unsigned cvt4_fp8(float a, float b, float c, float d) { int w = 0; w = __builtin_amdgcn_cvt_pk_fp8_f32(a, b, w, false); w = __builtin_amdgcn_cvt_pk_fp8_f32(c, d, w, true); return (unsigned)w; }
__device__ __forceinline__ unsigned cvtpk(float lo, float hi) { unsigned r; asm volatile("v_cvt_pk_bf16_f32 %0, %1, %2" : "=v"(r) : "v"(lo), "v"(hi)); return r; }
__device__ __forceinline__ float bf_lo(unsigned w) { return __uint_as_float(w << 16); }
__device__ __forceinline__ float bf_hi(unsigned w) { return __uint_as_float(w & 0xffff0000u); }
__device__ __forceinline__ float bf2f(bf16_t b) { return __uint_as_float(((unsigned)b) << 16); }
template <int K> __device__ __forceinline__ unsigned xshfl_u(unsigned v) {
    if constexpr (K == 1) return (unsigned)__builtin_amdgcn_update_dpp(0, (int)v, 0xB1, 0xf, 0xf, true);
    else if constexpr (K == 2) return (unsigned)__builtin_amdgcn_update_dpp(0, (int)v, 0x4E, 0xf, 0xf, true);
    else if constexpr (K == 4 || K == 8 || K == 16) return (unsigned)__builtin_amdgcn_ds_swizzle((int)v, (K << 10) | 0x1F);
    else { static_assert(K == 32, "xshfl: K");
        const auto r = __builtin_amdgcn_permlane32_swap(v, v, false, false);
        return (threadIdx.x & 32) ? r[0] : r[1]; }
}
template <int K> __device__ __forceinline__ float xshfl(float v) { return __uint_as_float(xshfl_u<K>(__float_as_uint(v))); }
__device__ __forceinline__ float wave_sum(float v) {
    v += xshfl<1>(v); v += xshfl<2>(v); v += xshfl<4>(v); v += xshfl<8>(v); v += xshfl<16>(v);
    { const auto r = __builtin_amdgcn_permlane32_swap(__float_as_uint(v), __float_as_uint(v), false, false); v = __uint_as_float(r[0]) + __uint_as_float(r[1]); }
    return v;
}
__device__ __forceinline__ float wave_max(float v) {
    v = fmaxf(v, xshfl<1>(v)); v = fmaxf(v, xshfl<2>(v)); v = fmaxf(v, xshfl<4>(v)); v = fmaxf(v, xshfl<8>(v)); v = fmaxf(v, xshfl<16>(v));
    { const auto r = __builtin_amdgcn_permlane32_swap(__float_as_uint(v), __float_as_uint(v), false, false); v = fmaxf(__uint_as_float(r[0]), __uint_as_float(r[1])); }
    return v;
}
__device__ __forceinline__ float dot2bf(unsigned a, unsigned b, float acc) { return __builtin_amdgcn_fdot2_f32_bf16(__builtin_bit_cast(bf16x2_t, a), __builtin_bit_cast(bf16x2_t, b), acc, false); }
__device__ __forceinline__ float gelu_tanh(float x) {
    const float z = x * (0.7978845608028654f + 0.035677408136300125f * x * x);
    const float e = __builtin_amdgcn_exp2f(-2.0f * LOG2E * z);
    return x * __builtin_amdgcn_rcpf(1.0f + e);
}
__device__ __forceinline__ float sigmoid_f(float x) { return __builtin_amdgcn_rcpf(1.0f + __builtin_amdgcn_exp2f(-LOG2E * x)); }

#define XB_TMO      128
#define XB_XCNT(j)  (256  + 64 * (j))
#define XB_XSUB(j)  (1280 + 64 * (j))
#define XB_XGEN(j)  (2304 + 64 * (j))
#define XB_TOP      3328
#define XB_TOPGEN   3392
#define XCD_BAR_WORDS 3456
#define XB_SPIN_CAP (1u << 18)

__device__ __forceinline__ unsigned xb_ld(unsigned* p)              { return __hip_atomic_load(p, __ATOMIC_RELAXED, __HIP_MEMORY_SCOPE_AGENT); }
__device__ __forceinline__ unsigned xb_add(unsigned* p, unsigned v) { return __hip_atomic_fetch_add(p, v, __ATOMIC_RELAXED, __HIP_MEMORY_SCOPE_AGENT); }
__device__ __forceinline__ unsigned xb_xcc_id() { return (unsigned)__builtin_amdgcn_s_getreg((3 << 11) | 20) & 0xFu; }
#define XB_SPIN(cond, bar) do { unsigned _sp = 0; while (cond) { __builtin_amdgcn_s_sleep(1); \
    if ((++_sp & 255u) == 0u) { if (xb_ld(&(bar)[XB_TMO])) break; if (_sp > XB_SPIN_CAP) { atomicAdd(&(bar)[XB_TMO], 1u); break; } } } } while (0)

struct XcdBarrier {
    unsigned* bar; unsigned x;
    volatile LAS unsigned* st;
};

__device__ __forceinline__ XcdBarrier xcd_barrier_post(unsigned* bar, volatile LAS unsigned* st) {
    XcdBarrier b; b.bar = bar; b.x = xb_xcc_id(); b.st = st;
    if (threadIdx.x == 0) (void)xb_add(&bar[XB_XCNT(b.x)], 1u);
    return b;
}
__device__ __forceinline__ void xcd_barrier_complete(unsigned* bar, unsigned x, unsigned& nloc, unsigned& nx) {
    const unsigned G = gridDim.x * gridDim.y * gridDim.z;
    unsigned sum, cnt, mine, sp = 0u;
    for (;;) {
        sum = 0u; cnt = 0u; mine = 0u;
#pragma unroll
        for (unsigned j = 0; j < 16; ++j) { const unsigned c = xb_ld(&bar[XB_XCNT(j)]); sum += c; cnt += (c > 0u) ? 1u : 0u; mine = (j == x) ? c : mine; }
        if (sum == G) break;
        __builtin_amdgcn_s_sleep(1);
        if ((++sp & 255u) == 0u) { if (xb_ld(&bar[XB_TMO])) break; if (sp > XB_SPIN_CAP) { atomicAdd(&bar[XB_TMO], 1u); break; } }
    }
    nloc = mine > 0u ? mine : 1u; nx = cnt > 0u ? cnt : 1u;
}

__device__ __forceinline__ void xcd_barrier(const XcdBarrier& b) {
    asm volatile("s_waitcnt vmcnt(0)" ::: "memory");
    __syncthreads();
    if (threadIdx.x == 0) {
        unsigned* bar = b.bar;
        __builtin_amdgcn_s_waitcnt(0);
        unsigned nloc = b.st[0], nx = b.st[1];
        if (nloc == 0u) { xcd_barrier_complete(bar, b.x, nloc, nx); b.st[0] = nloc; b.st[1] = nx; }
        const unsigned old = xb_add(&bar[XB_XSUB(b.x)], 1u);
        const unsigned gen = old / nloc;
        if (old + 1u == (gen + 1u) * nloc) {
            __builtin_amdgcn_fence(__ATOMIC_RELEASE, "agent");
            asm volatile("s_waitcnt vmcnt(0)" ::: "memory");
            const unsigned og = xb_add(&bar[XB_TOP], 1u);
            const unsigned tg = og / nx;
            if (og + 1u == (tg + 1u) * nx) xb_add(&bar[XB_TOPGEN], 1u);
            else XB_SPIN(xb_ld(&bar[XB_TOPGEN]) == tg, bar);
            __builtin_amdgcn_fence(__ATOMIC_ACQUIRE, "agent");
            xb_add(&bar[XB_XGEN(b.x)], 1u);
            asm volatile("s_waitcnt vmcnt(0)" ::: "memory");
        } else {
            XB_SPIN(xb_ld(&bar[XB_XGEN(b.x)]) == gen, bar);
            __builtin_amdgcn_fence(__ATOMIC_ACQUIRE, "agent");
            asm volatile("s_waitcnt vmcnt(0)" ::: "memory");
        }
    }
    __syncthreads();
}
namespace pg8 {
#define PG8_LAS __attribute__((address_space(3)))
typedef unsigned short bf16_t;
typedef short bf16x8 __attribute__((ext_vector_type(8)));
typedef float f32x4 __attribute__((ext_vector_type(4)));
typedef unsigned u32x4 __attribute__((ext_vector_type(4)));
constexpr int BM = 256, BK = 64, HALF = 128, HTB = HALF * BK * 2  , STAGE_BYTES = 8 * HTB, NXCD = 8, WGM = 8;

__host__ __device__ __forceinline__ int lds_byte(int r, int c) { const int st = (r >> 4) * 2 + (c >> 5), rr = r & 15, cc = c & 31, ob = rr * 64 + cc * 2; return st * 1024 + (ob ^ (((ob >> 9) & 1) << 5)); }
__host__ __device__ __forceinline__ void stage_rc(int b, int& R, int& C) { const int st = b / 1024, sb = b % 1024, swz = sb ^ (((sb >> 9) & 1) << 5); R = (st >> 1) * 16 + swz / 64; C = (st & 1) * 32 + (swz % 64) / 2; }
__host__ __device__ __forceinline__ int perm32(int rho) { const int n = rho >> 4, i = rho & 15; return 8 * (i >> 2) + 4 * n + (i & 3); }

struct Unit { int pm, pn; };
struct Gemm { const bf16_t* A; const bf16_t* Bt; int M, N, K; };

struct StaticOrder {
    int nM, nN, nwg, G, c;
    __host__ __device__ void init(int M, int N, int G_, int c_) { nM = M / BM; nN = N / BM; nwg = nM * nN; G = G_; c = c_; }
    __host__ __device__ __forceinline__ bool next(int i, Unit& u) const {
        const long L = (long)i * G + c; if (L >= nwg) return false;
        int wgid = (int)L; { const int q = nwg / NXCD, r = nwg % NXCD, xcd = wgid % NXCD, off = wgid / NXCD; wgid = (xcd < r ? xcd * (q + 1) : r * (q + 1) + (xcd - r) * q) + off; }
        const int nig = WGM * nN, gid = wgid / nig, fm = gid * WGM, gsz = (nM - fm) < WGM ? (nM - fm) : WGM;
        u.pm = fm + ((wgid % nig) % gsz); u.pn = (wgid % nig) / gsz; return true;
    }
    __device__ __forceinline__ void a_ready(const Unit&) const {}
    __device__ __forceinline__ void done(const Unit&) const {}
};
struct CountedOrder : StaticOrder {
    const unsigned* ready; unsigned need; unsigned* tmo;
    __device__ __forceinline__ void a_ready(const Unit& u) const {
        if (threadIdx.x < 64) {
            const unsigned long long t0 = __builtin_amdgcn_s_memrealtime(); unsigned polls = 0;
            while ((unsigned)__builtin_amdgcn_readfirstlane(__hip_atomic_load(ready + 64 * u.pm, __ATOMIC_RELAXED, __HIP_MEMORY_SCOPE_AGENT)) < need) {
                if ((++polls & 255u) == 0u && __builtin_amdgcn_readfirstlane(__hip_atomic_load(tmo, __ATOMIC_RELAXED, __HIP_MEMORY_SCOPE_AGENT)) != 0u) break;
                if (__builtin_amdgcn_s_memrealtime() - t0 > 2000000ull) {
                    if (threadIdx.x == 0) { unsigned expect = 0u; __hip_atomic_compare_exchange_strong(tmo + 1, &expect, 0x600u | (unsigned)(u.pm & 0xff), __ATOMIC_RELAXED, __ATOMIC_RELAXED, __HIP_MEMORY_SCOPE_AGENT); __hip_atomic_store(tmo, 1u, __ATOMIC_RELAXED, __HIP_MEMORY_SCOPE_AGENT); }
                    break; }
                __builtin_amdgcn_s_sleep(2); }
            __builtin_amdgcn_fence(__ATOMIC_ACQUIRE, "agent");
            asm volatile("s_waitcnt vmcnt(0)" ::: "memory");
        }
#if !defined(BROKEN_HOOK_NO_BARRIER)
        asm volatile("" ::: "memory"); __builtin_amdgcn_s_barrier(); asm volatile("" ::: "memory");
#endif
    }
};

__device__ __forceinline__ unsigned cvt_pk_bf16(float lo, float hi) { unsigned r; asm volatile("v_cvt_pk_bf16_f32 %0, %1, %2" : "=v"(r) : "v"(lo), "v"(hi)); return r; }
typedef float f32x2 __attribute__((ext_vector_type(2)));
__device__ __forceinline__ f32x2 gelu_pk(f32x2 v) {
    const f32x2 av = __builtin_elementwise_abs(v), d = av * 0.2316418882f + 1.0f;
    f32x2 t; t.x = __builtin_amdgcn_rcpf(d.x); t.y = __builtin_amdgcn_rcpf(d.y);
    f32x2 q = t * 0.5307027145f + (-0.7265760135f); q = q * t + 0.7107068705f; q = q * t + (-0.142248368f); q = q * t + 0.127414796f; q = q * t;
    const f32x2 s = (v * v) * (-0.72134752044f);
    f32x2 e; e.x = __builtin_amdgcn_exp2f(s.x); e.y = __builtin_amdgcn_exp2f(s.y);
    const f32x2 m = v * (q * e), r = v - m;
    f32x2 o; o.x = v.x < 0.f ? m.x : r.x; o.y = v.y < 0.f ? m.y : r.y; return o;
}


struct EpiProj {
    static constexpr bool PERM = true, AFTER_DRAIN = false, MIDK = false;
    bf16_t* outq; size_t reg_stride; const float* rstd1; const float* gq; const float* gk; PG8_LAS float* xch;
    __device__ __forceinline__ void operator()(const f32x4 (&acc)[2][2][4][2], const Unit& u, int wr, int wc, int fr, int fq) const {
        const int region = u.pn >> 3, pl = u.pn & 7;
        bf16_t* base = outq + (size_t)region * reg_stride;
        const int row0 = u.pm * BM + wr * 64 + fr;
        const int colL = pl * 256 + wc * 32 + 8 * fq;
        float rsv[2][4];
#pragma unroll
        for (int ai = 0; ai < 2; ++ai)
#pragma unroll
            for (int m = 0; m < 4; ++m) rsv[ai][m] = rstd1[row0 + ai * HALF + m * 16];
        if (region <= 1) {
            const float* g = (region == 0) ? gq : gk;
            const f32x4 g0 = *(const f32x4*)(g + wc * 32 + 8 * fq), g1 = *(const f32x4*)(g + wc * 32 + 8 * fq + 4);
#pragma unroll
            for (int ai = 0; ai < 2; ++ai)
#pragma unroll
                for (int m = 0; m < 4; ++m)
#pragma unroll
                    for (int bj = 0; bj < 2; ++bj) {
                        const f32x4 v0 = acc[ai][bj][m][0], v1 = acc[ai][bj][m][1];
                        float ss = (v0[0] * v0[0] + v0[1] * v0[1]) + (v0[2] * v0[2] + v0[3] * v0[3]) + (v1[0] * v1[0] + v1[1] * v1[1]) + (v1[2] * v1[2] + v1[3] * v1[3]);
                        ss *= rsv[ai][m] * rsv[ai][m];
                        ss += xshfl<16>(ss); ss += xshfl<32>(ss);
                        if (fq == 0) xch[((((wr * 2 + ai) * 4 + m) * 2 + bj) * 16 + fr) * 4 + wc] = ss;
                    }
            asm volatile("s_waitcnt lgkmcnt(0)" ::: "memory"); __builtin_amdgcn_s_barrier(); asm volatile("" ::: "memory");
#pragma unroll
            for (int ai = 0; ai < 2; ++ai)
#pragma unroll
                for (int m = 0; m < 4; ++m) {
                    bf16_t* rowp = base + (size_t)(row0 + ai * HALF + m * 16) * 2048 + colL;
#pragma unroll
                    for (int bj = 0; bj < 2; ++bj) {
                        const f32x4 p = *(const PG8_LAS f32x4*)(xch + ((((wr * 2 + ai) * 4 + m) * 2 + bj) * 16 + fr) * 4);
                        const float rn = __builtin_amdgcn_rsqf(((p[0] + p[1]) + (p[2] + p[3])) * (1.0f / 128.0f) + 1e-6f) * rsv[ai][m];
                        const f32x4 v0 = acc[ai][bj][m][0] * rn * g0, v1 = acc[ai][bj][m][1] * rn * g1;
                        u32x4 w; w.x = cvt_pk_bf16(v0[0], v0[1]); w.y = cvt_pk_bf16(v0[2], v0[3]); w.z = cvt_pk_bf16(v1[0], v1[1]); w.w = cvt_pk_bf16(v1[2], v1[3]);
                        *(u32x4*)(rowp + bj * HALF) = w;
                    }
                }
        } else {
#pragma unroll
            for (int ai = 0; ai < 2; ++ai)
#pragma unroll
                for (int m = 0; m < 4; ++m) {
                    bf16_t* rowp = base + (size_t)(row0 + ai * HALF + m * 16) * 2048 + colL;
                    const float rs = rsv[ai][m];
#pragma unroll
                    for (int bj = 0; bj < 2; ++bj) {
                        f32x4 v0 = acc[ai][bj][m][0] * rs, v1 = acc[ai][bj][m][1] * rs;
                        if (region == 4) {
#pragma unroll
                            for (int j = 0; j < 4; ++j) { v0[j] = gelu_tanh(v0[j]); v1[j] = gelu_tanh(v1[j]); }
                        }
                        u32x4 w; w.x = cvt_pk_bf16(v0[0], v0[1]); w.y = cvt_pk_bf16(v0[2], v0[3]); w.z = cvt_pk_bf16(v1[0], v1[1]); w.w = cvt_pk_bf16(v1[2], v1[3]);
                        *(u32x4*)(rowp + bj * HALF) = w;
                    }
                }
        }
    }
};
struct EpiOut {
    static constexpr bool PERM = true, AFTER_DRAIN = false, MIDK = true;
    const float* x; float* out; bf16_t* x2b; float* ssq2; const PG8_LAS float* rs; mutable int nu;
    __device__ __forceinline__ void midk(f32x4 (&acc)[2][2][4][2], const Unit&, int wr, int, int fr, int) const {
        const PG8_LAS float* t = rs + (nu & 3) * 512;
#pragma unroll
        for (int ai = 0; ai < 2; ++ai)
#pragma unroll
            for (int m = 0; m < 4; ++m) { const float f = t[ai * HALF + wr * 64 + m * 16 + fr];
#pragma unroll
                for (int bj = 0; bj < 2; ++bj)
#pragma unroll
                    for (int n = 0; n < 2; ++n) acc[ai][bj][m][n] = acc[ai][bj][m][n] * f; }
    }
    __device__ __forceinline__ void operator()(const f32x4 (&acc)[2][2][4][2], const Unit& u, int wr, int wc, int fr, int fq) const {
        const int row0 = u.pm * BM + wr * 64 + fr, col0 = u.pn * BM + wc * 32 + 8 * fq;
        const PG8_LAS float* t = rs + (nu & 3) * 512 + 256; ++nu;
#pragma unroll
        for (int ai = 0; ai < 2; ++ai) {
            f32x4 xv[4][2][2];
#pragma unroll
            for (int m = 0; m < 4; ++m)
#pragma unroll
                for (int bj = 0; bj < 2; ++bj) { const size_t o = (size_t)(row0 + ai * HALF + m * 16) * DM + col0 + bj * HALF; const u32x4 xw = *(const u32x4*)(x2b + o);
                    xv[m][bj][0] = (f32x4){bf_lo(xw.x), bf_hi(xw.x), bf_lo(xw.y), bf_hi(xw.y)}; xv[m][bj][1] = (f32x4){bf_lo(xw.z), bf_hi(xw.z), bf_lo(xw.w), bf_hi(xw.w)}; }
#pragma unroll
            for (int m = 0; m < 4; ++m) {
                const size_t row = (size_t)(row0 + ai * HALF + m * 16);
                const float rr = t[ai * HALF + wr * 64 + m * 16 + fr];
                float ss = 0.f;
#pragma unroll
                for (int bj = 0; bj < 2; ++bj) {
                    const size_t o = row * DM + col0 + bj * HALF;
                    const f32x4 v0 = acc[ai][bj][m][0] * rr + xv[m][bj][0], v1 = acc[ai][bj][m][1] * rr + xv[m][bj][1];
                    u32x4 w; w.x = cvt_pk_bf16(v0[0], v0[1]); w.y = cvt_pk_bf16(v0[2], v0[3]); w.z = cvt_pk_bf16(v1[0], v1[1]); w.w = cvt_pk_bf16(v1[2], v1[3]);
                    *(u32x4*)(x2b + o) = w;
                    ss += (v0[0] * v0[0] + v0[1] * v0[1]) + (v0[2] * v0[2] + v0[3] * v0[3]) + (v1[0] * v1[0] + v1[1] * v1[1]) + (v1[2] * v1[2] + v1[3] * v1[3]);
                }
                ss += xshfl<16>(ss); ss += xshfl<32>(ss);
                if (fq == 0) ssq2[row * 64 + u.pn * 4 + wc] = ss;
            }
        }
    }
};
struct EpiPq {
    static constexpr bool PERM = true, AFTER_DRAIN = false, MIDK = false;
    bf16_t* pq;
    __device__ __forceinline__ void operator()(const f32x4 (&acc)[2][2][4][2], const Unit& u, int wr, int wc, int fr, int fq) const {
        const int row0 = u.pm * BM + wr * 64 + fr, col0 = u.pn * BM + wc * 32 + 8 * fq;
#pragma unroll
        for (int ai = 0; ai < 2; ++ai)
#pragma unroll
            for (int m = 0; m < 4; ++m) {
                bf16_t* rowp = pq + (size_t)(row0 + ai * HALF + m * 16) * PQN + col0;
#pragma unroll
                for (int bj = 0; bj < 2; ++bj) {
                    const f32x4 v0 = acc[ai][bj][m][0], v1 = acc[ai][bj][m][1];
                    u32x4 w; w.x = cvt_pk_bf16(v0[0], v0[1]); w.y = cvt_pk_bf16(v0[2], v0[3]); w.z = cvt_pk_bf16(v1[0], v1[1]); w.w = cvt_pk_bf16(v1[2], v1[3]);
                    *(u32x4*)(rowp + bj * HALF) = w;
                }
            }
    }
};
typedef int i32x4g __attribute__((ext_vector_type(4)));
typedef int i32x8g __attribute__((ext_vector_type(8)));
__device__ __forceinline__ i32x8g cat8(bf16x8 a, bf16x8 b) { return __builtin_shufflevector(__builtin_bit_cast(i32x4g, a), __builtin_bit_cast(i32x4g, b), 0, 1, 2, 3, 4, 5, 6, 7); }
template <class Epi, class Sched, bool STAMP = false, bool F8 = false>
__device__ __forceinline__ void gemm_phase(PG8_LAS unsigned char* lds, const Gemm g, const Sched& S, const Epi& E, unsigned long long* stamps) {
    const int tid = threadIdx.x, wid = __builtin_amdgcn_readfirstlane(tid >> 6), lane = tid & 63, wr = wid >> 2, wc = wid & 3, fr = lane & 15, fq = lane >> 4;
    const int K = g.K, nt = K / BK;
    int ts_lo = 0, ts_hi = 0, nts = 0; const unsigned long long rt_entry = STAMP ? (unsigned long long)wall_clock64() : 0ull;
#define PG8_STAMP() do { if (STAMP && wid == 0 && nts < 64) { const unsigned long long _c = (unsigned long long)clock64(); \
        ts_lo = (lane == nts) ? (int)(unsigned)_c : ts_lo; ts_hi = (lane == nts) ? (int)(unsigned)(_c >> 32) : ts_hi; ++nts; } } while (0)
    PG8_STAMP();
    unsigned voffA[2], voffB[2];
#pragma unroll
    for (int i = 0; i < 2; ++i) { int R, C; stage_rc(tid * 16 + i * 8192, R, C); const int Rb = Epi::PERM ? ((R & ~31) + perm32(R & 31)) : R;
        voffA[i] = (unsigned)(R * K + C) * 2u; voffB[i] = (unsigned)(Rb * K + C) * 2u; }
    const size_t kstep = (size_t)(BK * 2);
    const size_t hstep = (size_t)HALF * K * 2;
    const size_t tstep = 2 * hstep;
    const unsigned ldsw = (unsigned)wid * 1024u;
    const int aoff = lds_byte(wr * 64 + fr, fq * 8), boff = lds_byte(wc * 32 + fr, fq * 8);
#define PG8_SA(b, h) (((b) * 2 + (h)) * HTB)
#define PG8_SB(b, h) ((4 + (b) * 2 + (h)) * HTB)
#define PG8_STAGE(bufoff, gbase, voff) do { _Pragma("unroll") for (int _i = 0; _i < 2; ++_i) { unsigned _vo = (voff)[_i]; asm volatile("" : "+v"(_vo));   \
        __builtin_amdgcn_global_load_lds((const unsigned*)((const char*)(gbase) + _vo), (PG8_LAS unsigned*)(lds + (bufoff) + ldsw + _i * 8192), 16, 0, 0); } } while (0)
#define PG8_LDA(dst, b, h) do { _Pragma("unroll") for (int m = 0; m < 4; ++m) _Pragma("unroll") for (int k = 0; k < 2; ++k) dst[m][k] = *(const PG8_LAS bf16x8*)(lds + PG8_SA(b, h) + aoff + m * 2048 + k * 1024); } while (0)
#define PG8_LDB(dst, b, h) do { _Pragma("unroll") for (int n = 0; n < 2; ++n) _Pragma("unroll") for (int k = 0; k < 2; ++k) dst[n][k] = *(const PG8_LAS bf16x8*)(lds + PG8_SB(b, h) + boff + n * 2048 + k * 1024); } while (0)
#define PG8_MMA(ai, bj, At, Bt) do { __builtin_amdgcn_s_setprio(1); _Pragma("unroll") for (int m = 0; m < 4; ++m) _Pragma("unroll") for (int n = 0; n < 2; ++n) { \
        if constexpr (F8) asm volatile("v_mfma_f32_16x16x128_f8f6f4 %0, %1, %2, %0" : "+v"(acc[ai][bj][m][n]) : "v"(cat8(Bt[n][0], Bt[n][1])), "v"(cat8(At[m][0], At[m][1])));   \
        else { _Pragma("unroll") for (int k = 0; k < 2; ++k) acc[ai][bj][m][n] = __builtin_amdgcn_mfma_f32_16x16x32_bf16(Bt[n][k], At[m][k], acc[ai][bj][m][n], 0, 0, 0); } } \
        __builtin_amdgcn_s_setprio(0); } while (0)
#define PG8_HAZ() asm volatile("s_nop 15\n\ts_nop 15" : "+v"(acc[1][1][0][0]), "+v"(acc[1][1][0][1]), "+v"(acc[1][1][1][0]), "+v"(acc[1][1][1][1]), "+v"(acc[1][1][2][0]), "+v"(acc[1][1][2][1]), "+v"(acc[1][1][3][0]), "+v"(acc[1][1][3][1]))
#define PG8_WAIT_V(n) asm volatile("s_waitcnt vmcnt(" #n ")" ::: "memory")
#define PG8_WAIT_L(n) asm volatile("s_waitcnt lgkmcnt(" #n ")" ::: "memory")
#define PG8_BAR __builtin_amdgcn_s_barrier()
#define PG8_SCHED __builtin_amdgcn_sched_barrier(0)
    Unit cur, nxt; int ui = 0;
    if (!S.next(0, cur)) return;
    f32x4 acc[2][2][4][2];
#pragma unroll
    for (int a = 0; a < 2; ++a)
#pragma unroll
        for (int b = 0; b < 2; ++b)
#pragma unroll
            for (int m = 0; m < 4; ++m)
#pragma unroll
                for (int n = 0; n < 2; ++n) acc[a][b][m][n] = (f32x4){0.f, 0.f, 0.f, 0.f};
    bf16x8 At[4][2], B0[2][2], B1[2][2];
    const char* cA = (const char*)g.A + (size_t)cur.pm * tstep; const char* cB = (const char*)g.Bt + (size_t)cur.pn * tstep;
    S.a_ready(cur);
    PG8_STAGE(PG8_SB(0, 0), cB, voffB); PG8_STAGE(PG8_SA(0, 0), cA, voffA); PG8_STAGE(PG8_SB(0, 1), cB + hstep, voffB); PG8_STAGE(PG8_SA(0, 1), cA + hstep, voffA);
    if (wr == 1) PG8_BAR;
    PG8_WAIT_V(4); PG8_BAR;
    PG8_STAGE(PG8_SB(1, 0), cB + kstep, voffB); PG8_STAGE(PG8_SA(1, 0), cA + kstep, voffA); PG8_STAGE(PG8_SB(1, 1), cB + hstep + kstep, voffB);
    PG8_WAIT_V(6); PG8_BAR;
    PG8_STAMP();
    for (;;) {
        const bool has_next = S.next(ui + 1, nxt);
        const char* nA = has_next ? (const char*)g.A + (size_t)nxt.pm * tstep : cA; const char* nB = has_next ? (const char*)g.Bt + (size_t)nxt.pn * tstep : cB;
        for (int t = 0; t < nt; t += 2) {
            if constexpr (Epi::MIDK) { if (t == nt / 2) { if constexpr (F8) PG8_HAZ(); int l2 = lane; asm volatile("" : "+v"(l2)); E.midk(acc, cur, wr, wc, l2 & 15, l2 >> 4); } }
            const bool last = (t == nt - 2);
            const char* a1 = cA + (size_t)(t + 1) * kstep;
            const char* a2 = last ? nA : cA + (size_t)(t + 2) * kstep; const char* b2 = last ? nB : cB + (size_t)(t + 2) * kstep;
            const char* a3 = a2 + kstep; const char* b3 = b2 + kstep;
            if (last && has_next) S.a_ready(nxt);
            PG8_LDB(B0, 0, 0); PG8_SCHED; PG8_LDA(At, 0, 0); PG8_STAGE(PG8_SA(1, 1), a1 + hstep, voffA);
            PG8_WAIT_L(8); PG8_BAR; PG8_WAIT_L(0); PG8_MMA(0, 0, At, B0); PG8_BAR; PG8_SCHED;
            PG8_LDB(B1, 0, 1); PG8_STAGE(PG8_SB(0, 0), b2, voffB);
            PG8_BAR; PG8_WAIT_L(0); PG8_MMA(0, 1, At, B1); PG8_BAR;
            PG8_LDA(At, 0, 1); PG8_STAGE(PG8_SA(0, 0), a2, voffA);
            PG8_BAR; PG8_WAIT_L(0); PG8_MMA(1, 0, At, B0); PG8_BAR; PG8_SCHED;
            PG8_STAGE(PG8_SB(0, 1), b2 + hstep, voffB);
            PG8_WAIT_V(6); PG8_BAR; PG8_MMA(1, 1, At, B1); PG8_BAR;
            PG8_LDB(B0, 1, 0); PG8_SCHED; PG8_LDA(At, 1, 0); PG8_STAGE(PG8_SA(0, 1), a2 + hstep, voffA);
            PG8_WAIT_L(8); PG8_BAR; PG8_WAIT_L(0); PG8_MMA(0, 0, At, B0); PG8_BAR; PG8_SCHED;
            PG8_LDB(B1, 1, 1); PG8_STAGE(PG8_SB(1, 0), b3, voffB);
            PG8_BAR; PG8_WAIT_L(0); PG8_MMA(0, 1, At, B1); PG8_BAR;
            PG8_LDA(At, 1, 1); PG8_STAGE(PG8_SA(1, 0), a3, voffA);
            PG8_BAR; PG8_WAIT_L(0); PG8_MMA(1, 0, At, B0); PG8_BAR; PG8_SCHED;
            PG8_STAGE(PG8_SB(1, 1), b3 + hstep, voffB);
            PG8_WAIT_V(6); PG8_BAR; PG8_MMA(1, 1, At, B1); PG8_BAR;
        }
        PG8_STAMP();
        if constexpr (F8) PG8_HAZ();
        if constexpr (!Epi::AFTER_DRAIN) { int l2 = lane; asm volatile("" : "+v"(l2));
            E(acc, cur, wr, wc, l2 & 15, l2 >> 4); S.done(cur); }
        PG8_STAMP();
        if (!has_next) break;
#pragma unroll
        for (int a = 0; a < 2; ++a)
#pragma unroll
            for (int b = 0; b < 2; ++b)
#pragma unroll
                for (int m = 0; m < 4; ++m)
#pragma unroll
                    for (int n = 0; n < 2; ++n) acc[a][b][m][n] = (f32x4){0.f, 0.f, 0.f, 0.f};
        cur = nxt; cA = nA; cB = nB; ++ui;
    }
    PG8_WAIT_V(0);
    if (wr == 0) PG8_BAR;
    PG8_BAR;
    if constexpr (Epi::AFTER_DRAIN) { E.fused(acc, cur, wr, wc, fr, fq, lds, wid, lane); S.done(cur); }
    PG8_STAMP();
    if (STAMP && wid == 0) { stamps[lane] = lane < nts ? (((unsigned long long)(unsigned)ts_hi << 32) | (unsigned)ts_lo) : 0ull;
        if (lane == 62) stamps[62] = rt_entry; if (lane == 63) stamps[63] = (unsigned long long)wall_clock64(); }
#undef PG8_STAMP
#undef PG8_SA
#undef PG8_SB
#undef PG8_STAGE
#undef PG8_LDA
#undef PG8_LDB
#undef PG8_MMA
#undef PG8_HAZ
#undef PG8_WAIT_V
#undef PG8_WAIT_L
#undef PG8_BAR
#undef PG8_SCHED
}
}

namespace att {
constexpr int LDK = 2048;
constexpr float SCALE = 0.088388347648318440f;
constexpr float THR2 = 8.f * LOG2E;
constexpr int SHM_V = 64 * 128 * 2, SHM_K = SHM_V;
constexpr int OFF_WS = 2 * SHM_V + 2 * SHM_K, OFF_TBL = OFF_WS + NWAVES * 64 * 4, OFF_Q = OFF_TBL + 704 * 4, ATT_LDS = OFF_Q + NWAVES * 8192;
static_assert(OFF_Q % 16 == 0 && ATT_LDS <= LDS_MISC, "attention LDS map");
#define KSWZ(row, colB) ((row) * 256 + ((colB) ^ (((row) & 7) << 4)))
#define SBAR() __builtin_amdgcn_sched_barrier(0)
__device__ __forceinline__ constexpr int crow(int r, int hi) { return (r & 3) + 8 * (r >> 2) + 4 * hi; }
__device__ __forceinline__ constexpr int kc(int r) { return (r & 3) + 8 * (r >> 2); }

__device__ __forceinline__ void partialSM(f32x16& p0, f32x16& p1, float& m_reg, float& alpha, const float* tp) {
    constexpr float C = SCALE * LOG2E;
#pragma unroll
    for (int r = 0; r < 16; ++r) { p0[r] = fmaf(p0[r], C, tp[59 - kc(r)]); p1[r] = fmaf(p1[r], C, tp[27 - kc(r)]); }
    float pmax = p0[0];
#pragma unroll
    for (int r = 1; r < 16; ++r) pmax = fmaxf(pmax, p0[r]);
#pragma unroll
    for (int r = 0; r < 16; ++r) pmax = fmaxf(pmax, p1[r]);
    { auto rr = __builtin_amdgcn_permlane32_swap(__float_as_uint(pmax), __float_as_uint(pmax), false, false);
      pmax = fmaxf(__uint_as_float(rr[0]), __uint_as_float(rr[1])); }
    float mn;
    if (__builtin_expect(__all(pmax - m_reg <= THR2), 1)) { mn = m_reg; alpha = 1.f; }
    else { mn = fmaxf(m_reg, pmax); alpha = __builtin_amdgcn_exp2f(m_reg - mn); m_reg = mn; }
#pragma unroll
    for (int r = 0; r < 16; ++r) { p0[r] = __builtin_amdgcn_exp2f(p0[r] - mn); p1[r] = p1[r] - mn; }
}
__device__ __forceinline__ void finishSM(f32x16& p0, f32x16& p1, float alpha, float& l_reg, bf16x8& pa0, bf16x8& pa1, bf16x8& pa2, bf16x8& pa3) {
#pragma unroll
    for (int r = 0; r < 16; ++r) p1[r] = __builtin_amdgcn_exp2f(p1[r]);
    float ps = 0;
#pragma unroll
    for (int r = 0; r < 16; ++r) ps += p0[r];
#pragma unroll
    for (int r = 0; r < 16; ++r) ps += p1[r];
    { auto rr = __builtin_amdgcn_permlane32_swap(__float_as_uint(ps), __float_as_uint(ps), false, false);
      ps = __uint_as_float(rr[0]) + __uint_as_float(rr[1]); }
    l_reg = l_reg * alpha + ps;
#define PK4(P, BASE, OUT) do { unsigned a0 = cvtpk(P[BASE + 0], P[BASE + 1]), a1 = cvtpk(P[BASE + 2], P[BASE + 3]);   \
    unsigned b0 = cvtpk(P[BASE + 4], P[BASE + 5]), b1 = cvtpk(P[BASE + 6], P[BASE + 7]);                              \
    auto r0 = __builtin_amdgcn_permlane32_swap(a0, b0, false, false); auto r1 = __builtin_amdgcn_permlane32_swap(a1, b1, false, false); \
    u32x4 w = {r0[0], r1[0], r0[1], r1[1]}; OUT = *reinterpret_cast<bf16x8*>(&w); } while (0)
    PK4(p0, 0, pa0); PK4(p0, 8, pa1); PK4(p1, 0, pa2); PK4(p1, 8, pa3);
#undef PK4
}
__device__ __forceinline__ void qkt(f32x16& p0, f32x16& p1, const char* Ks, const char* qs, int r32, int hi) {
    p0 = f32x16{}; p1 = f32x16{};
#pragma unroll
    for (int d0 = 0; d0 < 8; ++d0) { const int cb = (d0 * 16 + hi * 8) * 2;
        const bf16x8 b0 = *reinterpret_cast<const bf16x8*>(Ks + KSWZ(r32, cb));
        const bf16x8 b1 = *reinterpret_cast<const bf16x8*>(Ks + KSWZ(32 + r32, cb));
        const bf16x8 q = *reinterpret_cast<const bf16x8*>(qs + d0 * 1024);
        p0 = __builtin_amdgcn_mfma_f32_32x32x16_bf16(b0, q, p0, 0, 0, 0);
        p1 = __builtin_amdgcn_mfma_f32_32x32x16_bf16(b1, q, p1, 0, 0, 0); }
}
__device__ __forceinline__ int v_st(int k, int c) { const int kk = (k & ~0xC) | ((k & 4) << 1) | ((k & 8) >> 1); return ((kk >> 3) * 4 + (c >> 5)) * 512 + ((kk & 7) * 32 + (c & 31)) * 2; }
__device__ __forceinline__ int v_rd_base(int lane) { return ((lane & 3) << 3) | (((lane >> 2) & 3) << 6) | (((lane >> 4) & 1) << 5) | (((lane >> 5) & 1) << 8); }
constexpr int v_rd_off(int d0, int ks, int half) { return d0 * 512 + ks * 4096 + half * 2048; }
template <int OFF> __device__ __forceinline__ s16x4 tr_read(int vb) {
    s16x4 r; asm volatile("ds_read_b64_tr_b16 %0, %1 offset:%2" : "=&v"(r) : "v"(vb), "i"(OFF) : "memory"); return r;
}
template <int D0> __device__ __forceinline__ void pv_one(f32x16& od, int vb, bf16x8 pa0, bf16x8 pa1, bf16x8 pa2, bf16x8 pa3) {
    const s16x4 l0 = tr_read<v_rd_off(D0, 0, 0)>(vb), h0 = tr_read<v_rd_off(D0, 0, 1)>(vb), l1 = tr_read<v_rd_off(D0, 1, 0)>(vb), h1 = tr_read<v_rd_off(D0, 1, 1)>(vb);
    const s16x4 l2 = tr_read<v_rd_off(D0, 2, 0)>(vb), h2 = tr_read<v_rd_off(D0, 2, 1)>(vb), l3 = tr_read<v_rd_off(D0, 3, 0)>(vb), h3 = tr_read<v_rd_off(D0, 3, 1)>(vb);
    asm volatile("s_waitcnt lgkmcnt(0)" ::: "memory"); SBAR();
#define PKV(L, H) (bf16x8){L[0], L[1], L[2], L[3], H[0], H[1], H[2], H[3]}
    od = __builtin_amdgcn_mfma_f32_32x32x16_bf16(pa0, PKV(l0, h0), od, 0, 0, 0);
    od = __builtin_amdgcn_mfma_f32_32x32x16_bf16(pa1, PKV(l1, h1), od, 0, 0, 0);
    od = __builtin_amdgcn_mfma_f32_32x32x16_bf16(pa2, PKV(l2, h2), od, 0, 0, 0);
    od = __builtin_amdgcn_mfma_f32_32x32x16_bf16(pa3, PKV(l3, h3), od, 0, 0, 0);
#undef PKV
}
__device__ __forceinline__ void pv_d0(f32x16* o, int vb, bf16x8 pa0, bf16x8 pa1, bf16x8 pa2, bf16x8 pa3) {
    pv_one<0>(o[0], vb, pa0, pa1, pa2, pa3); pv_one<1>(o[1], vb, pa0, pa1, pa2, pa3); pv_one<2>(o[2], vb, pa0, pa1, pa2, pa3); pv_one<3>(o[3], vb, pa0, pa1, pa2, pa3);
}

__device__ __forceinline__ void attn_unit(const bf16_t* __restrict__ Q, const bf16_t* __restrict__ K, const bf16_t* __restrict__ V, const float* __restrict__ relb,
                                          bf16_t* __restrict__ mix, float* __restrict__ assq, int b, int h, int g, char* lds) {
    const int tid = threadIdx.x, wid = tid >> 6, lane = tid & 63, r32 = lane & 31, hi = lane >> 5;
    const int c0 = 4 * g, jp = wid >> 1;
    const size_t tokb = (size_t)b * SEQ;
    char* V_lds = lds; char* K_lds = lds + 2 * SHM_V;
    float* ws = (float*)(lds + OFF_WS) + wid * 64; float* li_l = ws; float* al_l = ws + 32;
    float* tbl = (float*)(lds + OFF_TBL);
    __syncthreads();
    for (int i = tid; i < 704; i += NTHREADS) { const int diff = i - 63; const int idx = (diff > 256 ? 256 : diff) + 256; tbl[i] = (i < 639) ? relb[h * NREL + idx] * LOG2E : -__builtin_inff(); }
    float m_reg = -1e30f, l_reg = 0.f; f32x16 o[4] = {};
    char* qr = lds + OFF_Q + wid * 8192 + lane * 16;
    const size_t qtok = tokb + (size_t)c0 * 64 + wid * 32;
    const bf16_t* Qw = Q + (qtok + r32) * LDK + h * HD + hi * 8;
#pragma unroll
    for (int d0 = 0; d0 < 8; ++d0) *reinterpret_cast<bf16x8*>(qr + d0 * 1024) = *reinterpret_cast<const bf16x8*>(Qw + d0 * 16);
    const int sr = tid >> 4, sc = (tid & 15) * 8, vst0 = v_st(sr, sc), vst1 = v_st(32 + sr, sc);
    const int vb0 = (int)(uintptr_t)V_lds + v_rd_base(lane);
    const bf16_t* Kh = K + tokb * LDK + h * HD + (size_t)sr * LDK + sc; const bf16_t* Vh = V + tokb * LDK + h * HD + (size_t)sr * LDK + sc;
    bf16x8 vs0, vs1, ks0, ks1;
#define KT(t) ((c0 - 8 + (t)) < 0 ? 0 : (c0 - 8 + (t)))
#define SLOAD(t) do { const size_t k0_ = (size_t)KT(t) * 64 * LDK; vs0 = *reinterpret_cast<const bf16x8*>(Vh + k0_); vs1 = *reinterpret_cast<const bf16x8*>(Vh + k0_ + 32 * LDK); \
    ks0 = *reinterpret_cast<const bf16x8*>(Kh + k0_); ks1 = *reinterpret_cast<const bf16x8*>(Kh + k0_ + 32 * LDK); } while (0)
#define SWRITE(t) do { const int bo_ = ((t) & 1) * SHM_V; *(bf16x8*)(V_lds + bo_ + vst0) = vs0; *(bf16x8*)(V_lds + bo_ + vst1) = vs1; const int kcB = sc * 2; \
    *(bf16x8*)(K_lds + bo_ + KSWZ(sr, kcB)) = ks0; *(bf16x8*)(K_lds + bo_ + KSWZ(32 + sr, kcB)) = ks1; } while (0)
#define RESC(a) do { if (__any((a) < 1.f)) { if (hi == 0) al_l[r32] = (a); asm volatile("s_waitcnt lgkmcnt(0)" ::: "memory"); \
    _Pragma("unroll") for (int d = 0; d < 4; ++d) _Pragma("unroll") for (int r = 0; r < 16; ++r) o[d][r] *= al_l[crow(r, hi)]; } } while (0)
#define TP(t) (((c0 - 8 + (t)) < 0) ? (tbl + 640) : (tbl + ((jp + 8 - (t)) * 64 + (wid & 1) * 32 + r32 + 4 - 4 * hi)))
#define KB(t) (K_lds + ((t) & 1) * SHM_K)
#define VB(t) (vb0 + ((t) & 1) * SHM_V)
#define ST_HEAD(t) do { if ((t) + 1 <= 11) SLOAD((t) + 1); } while (0)
#define ST_TAIL(t, resc) do { __syncthreads(); if ((t) + 1 <= 11) SWRITE((t) + 1); resc; __syncthreads(); } while (0)
    f32x16 pA0, pA1, pB0, pB1; float alA = 1.f, alB = 1.f; bf16x8 pa0, pa1, pa2, pa3;
    SLOAD(0); asm volatile("s_waitcnt vmcnt(0)" ::: "memory"); SWRITE(0); __syncthreads();
    int t = 0;
    for (; t < jp; ++t) { ST_HEAD(t); ST_TAIL(t, (void)0); }
    {
        SBAR(); qkt(pA0, pA1, KB(t), qr, r32, hi); ST_HEAD(t); SBAR();
        partialSM(pA0, pA1, m_reg, alA, TP(t));
        ST_TAIL(t, RESC(alA)); ++t;
    }
#pragma unroll 1
    for (int it = 0; it < 4; ++it) {
        {
            SBAR(); qkt(pB0, pB1, KB(t), qr, r32, hi);
            finishSM(pA0, pA1, alA, l_reg, pa0, pa1, pa2, pa3); SBAR();
            ST_HEAD(t); SBAR();
            pv_d0(o, VB(t - 1), pa0, pa1, pa2, pa3); partialSM(pB0, pB1, m_reg, alB, TP(t));
            ST_TAIL(t, RESC(alB)); ++t;
        }
        {
            SBAR(); qkt(pA0, pA1, KB(t), qr, r32, hi);
            finishSM(pB0, pB1, alB, l_reg, pa0, pa1, pa2, pa3); SBAR();
            ST_HEAD(t); SBAR();
            pv_d0(o, VB(t - 1), pa0, pa1, pa2, pa3); partialSM(pA0, pA1, m_reg, alA, TP(t));
            ST_TAIL(t, RESC(alA)); ++t;
        }
    }
    {
        finishSM(pA0, pA1, alA, l_reg, pa0, pa1, pa2, pa3); SBAR();
        if (t <= 11) ST_HEAD(t);
        SBAR(); pv_d0(o, VB(t - 1), pa0, pa1, pa2, pa3);
        if (t <= 11) { ST_TAIL(t, (void)0); }
        ++t;
    }
    for (; t <= 11; ++t) { ST_HEAD(t); ST_TAIL(t, (void)0); }
    if (hi == 0) li_l[r32] = l_reg;
    asm volatile("s_waitcnt lgkmcnt(0)" ::: "memory");
    int tid2 = tid; asm volatile("" : "+v"(tid2));
    const int lane2 = tid2 & 63, hi2 = lane2 >> 5, r32b = lane2 & 31, wid2 = tid2 >> 6;
    bf16_t* stg = (bf16_t*)(lds + OFF_Q + wid2 * 8192);
#pragma unroll
    for (int r = 0; r < 16; ++r) {
        const int orow = crow(r, hi2);
        const float rl = __builtin_amdgcn_rcpf(li_l[orow]);
#pragma unroll
        for (int d0 = 0; d0 < 4; ++d0) stg[orow * 128 + d0 * 32 + r32b] = (bf16_t)(cvtpk(o[d0][r] * rl, 0.f) & 0xffffu);
    }
    asm volatile("s_waitcnt lgkmcnt(0)" ::: "memory");
    {
        const int rsub = lane2 >> 4, c16 = lane2 & 15;
#pragma unroll
        for (int i = 0; i < 8; ++i) {
            const int row = 4 * i + rsub;
            const u32x4 w = *reinterpret_cast<const u32x4*>(stg + row * 128 + c16 * 8);
            float s = (bf_lo(w.x) * bf_lo(w.x) + bf_hi(w.x) * bf_hi(w.x)) + (bf_lo(w.y) * bf_lo(w.y) + bf_hi(w.y) * bf_hi(w.y)) + (bf_lo(w.z) * bf_lo(w.z) + bf_hi(w.z) * bf_hi(w.z)) + (bf_lo(w.w) * bf_lo(w.w) + bf_hi(w.w) * bf_hi(w.w));
            s += xshfl<1>(s); s += xshfl<2>(s); s += xshfl<4>(s); s += xshfl<8>(s);
            uint2 w8; w8.x = cvt4_fp8(bf_lo(w.x) * MIX_SA, bf_hi(w.x) * MIX_SA, bf_lo(w.y) * MIX_SA, bf_hi(w.y) * MIX_SA); w8.y = cvt4_fp8(bf_lo(w.z) * MIX_SA, bf_hi(w.z) * MIX_SA, bf_lo(w.w) * MIX_SA, bf_hi(w.w) * MIX_SA);
            *reinterpret_cast<uint2*>((unsigned char*)mix + (qtok + row) * DM + h * HD + c16 * 8) = w8;
            if (c16 == 0) assq[(qtok + row) * 16 + h] = s;
        }
    }
#undef KT
#undef SLOAD
#undef SWRITE
#undef RESC
#undef TP
#undef KB
#undef VB
#undef ST_HEAD
#undef ST_TAIL
}
}

namespace rec {
constexpr int XIN_OFF = 0, XIN_BYTES = 67 * 128 * 2;
constexpr int XRA_OFF = 17408, XRA_LD = 136;
constexpr int AL_OFF = 36864, UL_OFF = AL_OFF + 64 * 128 * 4, REC_LDS = UL_OFF + 64 * 128 * 4;
static_assert(XIN_BYTES <= XRA_OFF && XRA_OFF + 64 * XRA_LD * 2 <= AL_OFF, "rec LDS map");

__device__ __forceinline__ void rec_chain(const bf16_t* __restrict__ xrec, const bf16_t* __restrict__ gy, const float* __restrict__ conv_w, const float* __restrict__ conv_b,
                                          const bf16_t* __restrict__ wgt, const float* __restrict__ b_a, const float* __restrict__ b_x, const float* __restrict__ lam,
                                          bf16_t* __restrict__ mix, float* __restrict__ rssq, int b, int n, char* lds) {
    const int tid = threadIdx.x, wid = tid >> 6, lane = tid & 63, r32 = lane & 31, hi = lane >> 5, wr = wid >> 2, wc = wid & 3;
    bf16_t* xin = (bf16_t*)(lds + XIN_OFF); bf16_t* xra = (bf16_t*)(lds + XRA_OFF); float* aL = (float*)(lds + AL_OFF); float* uL = (float*)(lds + UL_OFF);
    const size_t tokb = (size_t)b * SEQ;
    const int cc = tid & 127, tq = tid >> 7, chg = n * RBD + cc;
    const float w0 = conv_w[0 * DREC + chg], w1 = conv_w[1 * DREC + chg], w2 = conv_w[2 * DREC + chg], w3 = conv_w[3 * DREC + chg], cb = conv_b[chg];
    const int cg = 32 * wc + r32, cgg = n * RBD + cg;
    const float ba = b_a[cgg], bx = b_x[cgg];
    const float sp8 = -8.0f * log1pf(expf(-lam[cgg])) * LOG2E;
    bf16x8 wa[8], wx[8];
#pragma unroll
    for (int s = 0; s < 8; ++s) {
        wa[s] = *reinterpret_cast<const bf16x8*>(wgt + ((size_t)(n * 2 + 0) * 128 + cg) * 128 + 16 * s + 8 * hi);
        wx[s] = *reinterpret_cast<const bf16x8*>(wgt + ((size_t)(n * 2 + 1) * 128 + cg) * 128 + 16 * s + 8 * hi);
    }
    __syncthreads();
    if (tid < 384) xin[tid] = 0;
    float hcar = 0.f;
    const int lrow = tid >> 3, lcol = (tid & 7) * 16;
    const bf16_t* xsrc = xrec + (tokb + lrow) * 2048 + n * RBD + lcol; const bf16_t* gsrc = gy + (tokb + lrow) * 2048 + n * RBD + lcol;
    u32x4 xn0 = *reinterpret_cast<const u32x4*>(xsrc), xn1 = *reinterpret_cast<const u32x4*>(xsrc + 8);
    u32x4 gn0 = *reinterpret_cast<const u32x4*>(gsrc), gn1 = *reinterpret_cast<const u32x4*>(gsrc + 8);
    for (int tile = 0; tile < SEQ / 64; ++tile) {
        const size_t t0 = tokb + (size_t)tile * 64;
        const u32x4 g0 = gn0, g1 = gn1;
        {
            *reinterpret_cast<u32x4*>(xin + (3 + lrow) * 128 + lcol) = xn0; *reinterpret_cast<u32x4*>(xin + (3 + lrow) * 128 + lcol + 8) = xn1;
            if (tile + 1 < SEQ / 64) {
                const size_t o = (size_t)(tile + 1) * 64 * 2048;
                xn0 = *reinterpret_cast<const u32x4*>(xsrc + o); xn1 = *reinterpret_cast<const u32x4*>(xsrc + o + 8);
                gn0 = *reinterpret_cast<const u32x4*>(gsrc + o); gn1 = *reinterpret_cast<const u32x4*>(gsrc + o + 8);
            }
        }
        __syncthreads();
        {
            float x0 = bf2f(xin[(16 * tq + 0) * 128 + cc]), x1 = bf2f(xin[(16 * tq + 1) * 128 + cc]), x2 = bf2f(xin[(16 * tq + 2) * 128 + cc]);
#pragma unroll
            for (int tt = 0; tt < 16; ++tt) {
                const float x3 = bf2f(xin[(16 * tq + tt + 3) * 128 + cc]);
                const float v = cb + w0 * x0 + w1 * x1 + w2 * x2 + w3 * x3;
                xra[(16 * tq + tt) * XRA_LD + cc] = (bf16_t)(cvtpk(v, 0.f) & 0xffffu);
                x0 = x1; x1 = x2; x2 = x3;
            }
        }
        __syncthreads();
        if (tid < 384) xin[tid] = xin[64 * 128 + tid];
        {
            f32x16 ga = {}, gx = {};
#pragma unroll
            for (int s = 0; s < 8; ++s) {
                const bf16x8 af = *reinterpret_cast<const bf16x8*>(xra + (32 * wr + r32) * XRA_LD + 16 * s + 8 * hi);
                ga = __builtin_amdgcn_mfma_f32_32x32x16_bf16(af, wa[s], ga, 0, 0, 0);
                gx = __builtin_amdgcn_mfma_f32_32x32x16_bf16(af, wx[s], gx, 0, 0, 0);
            }
#pragma unroll
            for (int r = 0; r < 16; ++r) {
                const int t = 32 * wr + att::crow(r, hi);
                const float xv = bf2f(xra[t * XRA_LD + cg]);
                const float rg = sigmoid_f(ga[r] + ba), ig = sigmoid_f(gx[r] + bx);
                const float l2a = sp8 * rg;
                const float av = __builtin_amdgcn_exp2f(l2a);
                const float xx = 2.0f * 0.6931471805599453f * l2a;
                const float poly = -xx * (1.0f + xx * (0.5f + xx * (0.16666667f + xx * (0.041666668f + xx * (0.008333334f + xx * 0.0013888889f)))));
                const float om = (xx > -0.3f) ? poly : (1.0f - av * av);
                const float mult = __builtin_amdgcn_sqrtf(om);
                aL[t * 128 + cg] = av; uL[t * 128 + cg] = mult * ig * xv;
            }
        }
        __syncthreads();
        if (tid < 128) {
#pragma unroll 1
            for (int tb = 0; tb < 64; tb += 16) {
                float av[16], uv[16];
#pragma unroll
                for (int i = 0; i < 16; ++i) { av[i] = aL[(tb + i) * 128 + tid]; uv[i] = uL[(tb + i) * 128 + tid]; }
#pragma unroll
                for (int i = 0; i < 16; ++i) { hcar = fmaf(av[i], hcar, uv[i]); uv[i] = hcar; }
#pragma unroll
                for (int i = 0; i < 16; ++i) uL[(tb + i) * 128 + tid] = uv[i];
            }
        }
        __syncthreads();
        {
            const float* hp = uL + lrow * 128 + lcol;
            float ss = 0.f; float a[16];
#pragma unroll
            for (int j = 0; j < 4; ++j) { a[2 * j] = hp[2 * j] * bf_lo(g0[j]); a[2 * j + 1] = hp[2 * j + 1] * bf_hi(g0[j]); a[8 + 2 * j] = hp[8 + 2 * j] * bf_lo(g1[j]); a[8 + 2 * j + 1] = hp[8 + 2 * j + 1] * bf_hi(g1[j]); }
            u32x4 o;
#pragma unroll
            for (int j = 0; j < 4; ++j) { ss += (a[4 * j] * a[4 * j] + a[4 * j + 1] * a[4 * j + 1]) + (a[4 * j + 2] * a[4 * j + 2] + a[4 * j + 3] * a[4 * j + 3]);
                o[j] = cvt4_fp8(a[4 * j] * MIX_SR, a[4 * j + 1] * MIX_SR, a[4 * j + 2] * MIX_SR, a[4 * j + 3] * MIX_SR); }
            unsigned char* dst = (unsigned char*)mix + (t0 + lrow) * DM + DATT + n * RBD + lcol;
            *reinterpret_cast<u32x4*>(dst) = o;
            ss += xshfl<1>(ss); ss += xshfl<2>(ss); ss += xshfl<4>(ss);
            if ((tid & 7) == 0) rssq[(t0 + lrow) * 16 + n] = ss;
        }
        __syncthreads();
    }
}
}

#ifndef TABLES_IN_P2
#define TABLES_IN_P2 1
#endif
struct Args {
    const float* in[22]; float* out; unsigned char* ws; int ph_lo, ph_hi;
};
struct TDesc { const float* src; bf16_t* dst; const float* gain; int K, N, k0, n0, f8; };
constexpr int TT = 128, TLD = 129;
__device__ __forceinline__ TDesc tile_desc(const Args& a, int t) {
    unsigned char* ws = a.ws; unsigned char* sm = ws + WS_SMALL;
    constexpr int n_in = (DM / TT) * (NIN / TT), n_out = (DM / TT) * (DM / TT), n_pq = (DM / TT) * (PQN / TT);
    TDesc d;
    if (t < n_in) { const int kt = t / (NIN / TT), nt = t % (NIN / TT); d = TDesc{a.in[2], (bf16_t*)(ws + WS_WIN), a.in[1], DM, NIN, kt * TT, nt * TT, 0}; }
    else if (t < n_in + n_out) { const int u = t - n_in, kt = u / (DM / TT), nt = u % (DM / TT); d = TDesc{a.in[15], (bf16_t*)(ws + WS_WOUT), kt * TT < DATT ? a.in[13] : a.in[14] - DATT, DM, DM, kt * TT, nt * TT, 1}; }
    else if (t < n_in + n_out + n_pq) { const int u = t - n_in - n_out, kt = u / (PQN / TT), nt = u % (PQN / TT); d = TDesc{a.in[17], (bf16_t*)(ws + WS_WPQ), a.in[16], DM, PQN, kt * TT, nt * TT, 0}; }
    else { const int u = t - n_in - n_out - n_pq, blk = u >> 1, gate = u & 1;
           d = TDesc{a.in[gate ? 10 : 8] + (size_t)blk * 128 * 128, (bf16_t*)(sm + SM_WGT) + (size_t)(blk * 2 + gate) * 128 * 128, nullptr, 128, 128, 0, 0, 0}; }
    return d;
}
__device__ __forceinline__ void tile_load(const TDesc& d, int tid, f32x4 (&v)[8]) {
    const int r = tid >> 5, c4 = (tid & 31) * 4;
    const float* p = d.src + (size_t)(d.k0 + r) * d.N + d.n0 + c4;
#pragma unroll
    for (int j = 0; j < 8; ++j) v[j] = *reinterpret_cast<const f32x4*>(p + (size_t)(16 * j) * d.N);
    if (d.gain) { const float sc = d.f8 ? W8S : 1.0f;
#pragma unroll
        for (int j = 0; j < 8; ++j) v[j] = v[j] * (d.gain[d.k0 + r + 16 * j] * sc); }
}
__device__ __forceinline__ void tile_store(const TDesc& d, int tid, const f32x4 (&v)[8], float* tile) {
    const int r = tid >> 5, c4 = (tid & 31) * 4;
#pragma unroll
    for (int j = 0; j < 8; ++j) { float* tp = tile + (r + 16 * j) * TLD + c4; tp[0] = v[j][0]; tp[1] = v[j][1]; tp[2] = v[j][2]; tp[3] = v[j][3]; }
    __syncthreads();
    const int nn = tid >> 2, kq = (tid & 3) * 32;
    const float* cp = tile + kq * TLD + nn;
    if (d.f8) { u32x4 o[2];
#pragma unroll
        for (int i = 0; i < 8; ++i) o[i >> 2][i & 3] = cvt4_fp8(cp[(4 * i) * TLD], cp[(4 * i + 1) * TLD], cp[(4 * i + 2) * TLD], cp[(4 * i + 3) * TLD]);
        u32x4* dp = reinterpret_cast<u32x4*>((unsigned char*)d.dst + (size_t)(d.n0 + nn) * d.K + d.k0 + kq); dp[0] = o[0]; dp[1] = o[1]; }
    else { u32x4 o[4];
#pragma unroll
        for (int i = 0; i < 16; ++i) o[i >> 2][i & 3] = cvtpk(cp[(2 * i) * TLD], cp[(2 * i + 1) * TLD]);
        u32x4* dp = reinterpret_cast<u32x4*>(d.dst + (size_t)(d.n0 + nn) * d.K + d.k0 + kq); dp[0] = o[0]; dp[1] = o[1]; dp[2] = o[2]; dp[3] = o[3]; }
    __syncthreads();
}
constexpr int NT_IN = (DM / TT) * (NIN / TT), NT_OUT = (DM / TT) * (DM / TT), NT_PQ = (DM / TT) * (PQN / TT), NT_GATE = 16 * 2;
template <bool P0MAP>
__device__ __forceinline__ void transpose_seq(const Args& a, char* lds, int first, int step, int n) {
    int tid = threadIdx.x; asm volatile("" : "+v"(tid));
    float* tile = (float*)lds;
    auto tmap = [](int c) { return P0MAP ? (c < NT_IN ? c : c + NT_OUT + NT_PQ) : NT_IN + c; };
    int t = first;
    if (t < n) {
        TDesc cur = tile_desc(a, tmap(t)); f32x4 c[8]; tile_load(cur, tid, c);
        for (;;) {
            const int tn = t + step; const bool more = tn < n;
            TDesc nxt = cur; f32x4 nn[8];
#pragma unroll
            for (int j = 0; j < 8; ++j) nn[j] = c[j];
            if (more) { nxt = tile_desc(a, tmap(tn)); tile_load(nxt, tid, nn); }
            tile_store(cur, tid, c, tile);
            if (!more) break;
            cur = nxt; t = tn;
#pragma unroll
            for (int j = 0; j < 8; ++j) c[j] = nn[j];
        }
    }
}
constexpr int TR_ITEM_TILES = 8, TR_ITEMS = (NT_OUT + NT_PQ) / TR_ITEM_TILES;
__device__ __forceinline__ void p0_tables_rows(const Args& a, int r0, int rstep, int rend) {
    int tid = threadIdx.x; asm volatile("" : "+v"(tid)); const int lane = tid & 63;
    unsigned char* ws = a.ws; unsigned char* sm = ws + WS_SMALL;
    {
        const float* g2 = a.in[16];
        float* su = (float*)(sm + SM_SU); float* sv = (float*)(sm + SM_SV); float* rsum = (float*)(sm + SM_RSUM);
        int r = r0;
        f32x4 nq[16];
        if (r < rend) { const float* s0 = (r >= NEXP ? a.in[21] + (size_t)(r - NEXP) * DM : a.in[20] + (size_t)r * DM) + lane * 4;
#pragma unroll
            for (int i = 0; i < 16; ++i) nq[i] = *reinterpret_cast<const f32x4*>(s0 + 256 * i); }
        for (; r < rend; r += rstep) {
            const bool isv = r >= NEXP; const int e = isv ? r - NEXP : r;
            f32x4 q[16]; float mx = 0.f, ss = 0.f;
#pragma unroll
            for (int i = 0; i < 16; ++i) q[i] = nq[i];
            { const int rn = r + rstep;
              if (rn < rend) { const float* s1 = (rn >= NEXP ? a.in[21] + (size_t)(rn - NEXP) * DM : a.in[20] + (size_t)rn * DM) + lane * 4;
#pragma unroll
                for (int i = 0; i < 16; ++i) nq[i] = *reinterpret_cast<const f32x4*>(s1 + 256 * i); } }
#pragma unroll
            for (int i = 0; i < 16; ++i) {
                f32x4 x = q[i];
                if (!isv) { const f32x4 gg = *reinterpret_cast<const f32x4*>(g2 + lane * 4 + 256 * i); x = x * gg; }
                q[i] = x;
                mx = fmaxf(mx, fmaxf(fmaxf(fabsf(x[0]), fabsf(x[1])), fmaxf(fabsf(x[2]), fabsf(x[3]))));
                ss += (x[0] * x[0] + x[1] * x[1]) + (x[2] * x[2] + x[3] * x[3]);
            }
            mx = wave_max(mx);
            mx = fmaxf(mx, 1e-30f);
            unsigned wd[8];
            if (isv) {
                const float sc = 6.0f / mx;
                if (lane == 0) sv[e] = mx * (1.0f / 6.0f);
#pragma unroll
                for (int d = 0; d < 8; ++d) {
                    unsigned w = 0;
                    w = __builtin_amdgcn_cvt_scalef32_pk_fp4_f32(w, q[2 * d][0] * sc, q[2 * d][1] * sc, 1.0f, 0);
                    w = __builtin_amdgcn_cvt_scalef32_pk_fp4_f32(w, q[2 * d][2] * sc, q[2 * d][3] * sc, 1.0f, 1);
                    w = __builtin_amdgcn_cvt_scalef32_pk_fp4_f32(w, q[2 * d + 1][0] * sc, q[2 * d + 1][1] * sc, 1.0f, 2);
                    w = __builtin_amdgcn_cvt_scalef32_pk_fp4_f32(w, q[2 * d + 1][2] * sc, q[2 * d + 1][3] * sc, 1.0f, 3);
                    wd[d] = w;
                }
            } else {
                ss = wave_sum(ss);
                const float step = fmaxf(fmaxf(0.335f * sqrtf(ss * (1.0f / DM)), mx * 0.05f), 1e-30f);
                const float inv = 1.0f / step;
                int qs = 0;
#pragma unroll
                for (int d = 0; d < 8; ++d) {
                    unsigned w = 0;
#pragma unroll
                    for (int j = 0; j < 8; ++j) {
                        const float xv = q[2 * d + (j >> 2)][j & 3];
                        const int qi = (int)fminf(fmaxf(rintf(xv * inv), -8.0f), 7.0f);
                        qs += qi;
                        w |= (unsigned)(qi & 15) << (4 * j);
                    }
                    wd[d] = w;
                }
                const float qsf = wave_sum((float)qs);
                if (lane == 0) { su[e] = step; rsum[e] = qsf; }
            }
            unsigned char* dst = ws + (isv ? WS_VB : WS_UB) + (size_t)e * V4ROW + lane * 16;
            *reinterpret_cast<u32x4*>(dst) = (u32x4){wd[0], wd[1], wd[2], wd[3]};
            *reinterpret_cast<u32x4*>(dst + 1024) = (u32x4){wd[4], wd[5], wd[6], wd[7]};
        }
    }
}
__device__ __forceinline__ void p0_tables(const Args& a) {
    p0_tables_rows(a, (int)blockIdx.x * NWAVES + ((int)threadIdx.x >> 6), (int)gridDim.x * NWAVES, 2 * NEXP);
}
constexpr int TBL_ITEMS = 2 * NEXP / 64;
__device__ __forceinline__ void p0_tables_item(const Args& a, int item) {
    const int r0 = item * 64 + ((int)threadIdx.x >> 6) * 8;
    p0_tables_rows(a, r0, 1, r0 + 8);
}
__device__ __forceinline__ void p0_prologue(const Args& a, char* lds) {
    const int tid = threadIdx.x, lane = tid & 63, wid = tid >> 6, G = gridDim.x, bid = blockIdx.x;
    unsigned char* ws = a.ws; unsigned char* sm = ws + WS_SMALL;
    {
        const float* x = a.in[0]; bf16_t* xb = (bf16_t*)(ws + WS_XB); float* rstd1 = (float*)(sm + SM_RSTD1);
        const int rstep = G * NWAVES; int row = bid * NWAVES + wid;
        f32x4 nx[16];
        if (row < TOK) { const f32x4* s0 = reinterpret_cast<const f32x4*>(x + (size_t)row * DM);
#pragma unroll
            for (int i = 0; i < 16; ++i) nx[i] = s0[lane + 64 * i]; }
        for (; row < TOK; row += rstep) {
            uint2* dst = reinterpret_cast<uint2*>(xb + (size_t)row * DM);
            f32x4 cx[16];
#pragma unroll
            for (int i = 0; i < 16; ++i) cx[i] = nx[i];
            if (row + rstep < TOK) { const f32x4* s1 = reinterpret_cast<const f32x4*>(x + (size_t)(row + rstep) * DM);
#pragma unroll
                for (int i = 0; i < 16; ++i) nx[i] = s1[lane + 64 * i]; }
            float ss = 0.f;
#pragma unroll
            for (int i = 0; i < 16; ++i) {
                const f32x4 p = cx[i];
                ss += (p[0] * p[0] + p[1] * p[1]) + (p[2] * p[2] + p[3] * p[3]);
                uint2 o; o.x = cvtpk(p[0], p[1]); o.y = cvtpk(p[2], p[3]);
                dst[lane + 64 * i] = o;
            }
            ss = wave_sum(ss);
            if (lane == 0) rstd1[row] = __builtin_amdgcn_rsqf(ss * (1.0f / DM) + EPS);
        }
    }
#if TABLES_IN_P2
    transpose_seq<true>(a, lds, bid, G, NT_IN + NT_GATE);
#else
    { float* tile = (float*)lds; int tidl = tid;
      constexpr int n_tiles = NT_IN + NT_OUT + NT_PQ + NT_GATE;
      int t = bid;
      if (t < n_tiles) {
          TDesc cur = tile_desc(a, t); f32x4 c[8]; tile_load(cur, tidl, c);
          for (;;) {
              const int tn = t + G; const bool more = tn < n_tiles;
              TDesc nxt = cur; f32x4 n[8];
#pragma unroll
              for (int j = 0; j < 8; ++j) n[j] = c[j];
              if (more) { nxt = tile_desc(a, tn); tile_load(nxt, tidl, n); }
              tile_store(cur, tidl, c, tile);
              if (!more) break;
              cur = nxt; t = tn;
#pragma unroll
              for (int j = 0; j < 8; ++j) c[j] = n[j];
          }
      }
    }
#endif
    {
        const size_t gt = (size_t)bid * NTHREADS + tid, nth = (size_t)G * NTHREADS;
        const size_t nk8 = (size_t)PH * PNK * 128 / 8;
        u32x4* kb = reinterpret_cast<u32x4*>(sm + SM_KEYS);
        for (size_t i = gt; i < 2 * nk8; i += nth) {
            const f32x4* ks = reinterpret_cast<const f32x4*>(i < nk8 ? a.in[18] : a.in[19]); const size_t j = i < nk8 ? i : i - nk8;
            const f32x4 p = ks[2 * j], q = ks[2 * j + 1];
            u32x4 o; o.x = cvtpk(p[0], p[1]); o.y = cvtpk(p[2], p[3]); o.z = cvtpk(q[0], q[1]); o.w = cvtpk(q[2], q[3]);
            kb[i] = o;
        }
    }
}


namespace peer {
constexpr int SKEY = 0, SEL_G = 64 * 128 * 4, ABUFO = 2 * 64 * 128 * 4, SCR = 3 * 64 * 128 * 4, R2 = SCR + NWAVES * 32 * 32 * 4, SXL = R2 + 64 * 4, PEER_LDS = SXL + 64 * 4;
static_assert(PEER_LDS <= LDS_MISC, "peer LDS map");
#ifndef PEER_WBITS
#define PEER_WBITS 11
#endif
constexpr int WSHIFT = 7 + PEER_WBITS;
constexpr int NWIN = NEXP >> PEER_WBITS;
constexpr int UCH = 8, VCH = 8;
constexpr int UG = 4, UR = 8 / UG;
constexpr float NEG = -3.0e38f;

__device__ __forceinline__ void ins16(float (&t)[16], float x) {
#pragma unroll
    for (int i = 0; i < 16; ++i) { const float hi = fmaxf(t[i], x); x = fminf(t[i], x); t[i] = hi; }
}
__device__ __forceinline__ void sort16(float (&t)[16]) {
#define SCE(K, J) _Pragma("unroll") for (int i = 0; i < 16; ++i) { const int l = i ^ (J); if (l > i) { const float hi = fmaxf(t[i], t[l]), lo = fminf(t[i], t[l]); \
        if ((i & (K)) == 0) { t[i] = hi; t[l] = lo; } else { t[i] = lo; t[l] = hi; } } }
    SCE(2, 1) SCE(4, 2) SCE(4, 1) SCE(8, 4) SCE(8, 2) SCE(8, 1) SCE(16, 8) SCE(16, 4) SCE(16, 2) SCE(16, 1)
#undef SCE
}
__device__ __forceinline__ void merge16(float (&t)[16], const float (&b)[16]) {
#pragma unroll
    for (int i = 0; i < 16; ++i) t[i] = fmaxf(t[i], b[15 - i]);
#define MCE(D) _Pragma("unroll") for (int i = 0; i < 16; ++i) if ((i & (D)) == 0) { const float hi = fmaxf(t[i], t[i + (D)]), lo = fminf(t[i], t[i + (D)]); t[i] = hi; t[i + (D)] = lo; }
    MCE(8) MCE(4) MCE(2) MCE(1)
#undef MCE
}
__device__ __forceinline__ void merge_partner(float (&t)[16]) {
    float m[16];
#pragma unroll
    for (int i = 0; i < 16; ++i) { const float p = xshfl<32>(t[15 - i]); m[i] = fmaxf(t[i], p); }
#define CE_STAGE(d) _Pragma("unroll") for (int i = 0; i < 16; ++i) if ((i & (d)) == 0) { const float hi = fmaxf(m[i], m[i + (d)]), lo = fminf(m[i], m[i + (d)]); m[i] = hi; m[i + (d)] = lo; }
    CE_STAGE(8) CE_STAGE(4) CE_STAGE(2) CE_STAGE(1)
#undef CE_STAGE
#pragma unroll
    for (int i = 0; i < 16; ++i) t[i] = m[i];
}
__device__ __forceinline__ void side_topk(const bf16_t* __restrict__ qb, const bf16_t* __restrict__ kb, float rs, int r32, int hi, float (&t)[16]) {
    bf16x8 qf[8];
#pragma unroll
    for (int s = 0; s < 8; ++s) qf[s] = *reinterpret_cast<const bf16x8*>(qb + 16 * s);
#pragma unroll
    for (int nb = 0; nb < 4; ++nb) {
        f32x16 acc = {};
        const bf16_t* kr = kb + (size_t)(32 * nb + r32) * 128 + 8 * hi;
#pragma unroll
        for (int s = 0; s < 8; ++s) { const bf16x8 kf = *reinterpret_cast<const bf16x8*>(kr + 16 * s); acc = __builtin_amdgcn_mfma_f32_32x32x16_bf16(kf, qf[s], acc, 0, 0, 0); }
        float blk[16];
#pragma unroll
        for (int r = 0; r < 16; ++r) {
            const unsigned n = 32 * nb + att::crow(r, hi);
            blk[r] = __uint_as_float((__float_as_uint(acc[r] * rs) & ~127u) | n);
        }
        sort16(blk);
        if (nb == 0) {
#pragma unroll
            for (int i = 0; i < 16; ++i) t[i] = blk[i];
        } else merge16(t, blk);
    }
    merge_partner(t);
}

__device__ __forceinline__ void xcc_rendezvous(const XcdBarrier& b, unsigned* cnt) {
    __syncthreads();
    if (threadIdx.x == 0) {
        const unsigned nloc = b.st[0];
        if (nloc) { unsigned* w = cnt + 64 * b.x; __hip_atomic_fetch_add(w, 1u, RLX_AGENT);
            unsigned sp = 0; while (__hip_atomic_load(w, RLX_AGENT) < nloc && ++sp < (1u << 15)) __builtin_amdgcn_s_sleep(1); }
    }
    __syncthreads();
}
__device__ __forceinline__ void peer_unit(const Args& a, int unit, char* lds, float* outw, const XcdBarrier& gbar, unsigned* rcnt, bool rdv) {
    int tid = threadIdx.x; asm volatile("" : "+v"(tid));
    const int wid = tid >> 6, lane = tid & 63, r32 = lane & 31, hi = lane >> 5;
    unsigned char* sm = a.ws + WS_SMALL;
    const bf16_t* pq = (const bf16_t*)(a.ws + WS_Q); const bf16_t* keys = (const bf16_t*)(sm + SM_KEYS); const float* ssq2 = (const float*)(sm + SM_SSQ2);
    const bf16_t* x2b = (const bf16_t*)(a.ws + WS_XB); const unsigned char* ub = a.ws + WS_UB; const unsigned char* vb = a.ws + WS_VB;
    const float* su = (const float*)(sm + SM_SU); const float* sv = (const float*)(sm + SM_SV); const float* rsum = (const float*)(sm + SM_RSUM);
    float* sxl = (float*)(lds + SXL);
    unsigned* skey = (unsigned*)(lds + SKEY); float* sel_g = (float*)(lds + SEL_G); float* abuf = (float*)(lds + ABUFO); float* scr = (float*)(lds + SCR) + wid * 1024; float* r2 = (float*)(lds + R2);
    const size_t tok0 = (size_t)unit * 64;
    __syncthreads();
#pragma unroll
    for (int j = 0; j < 8; ++j) {
        const int tl = wid * 8 + j; float s = ssq2[(tok0 + tl) * 64 + lane]; s = wave_sum(s);
        if (lane == 0) r2[tl] = __builtin_amdgcn_rsqf(s * (1.0f / DM) + EPS);
    }
    __syncthreads();
#pragma unroll 1
    for (int task = wid; task < 16; task += NWAVES) {
        const int tg = task & 1, hh = task >> 1, tl = 32 * tg + r32;
        const float rs = r2[tl];
        const bf16_t* qrow = pq + (tok0 + tl) * PQN + hh * PQD + 8 * hi;
        float t1[16], t2[16];
        side_topk(qrow, keys + (size_t)(0 * PH + hh) * PNK * 128, rs, r32, hi, t1);
        side_topk(qrow + 128, keys + (size_t)(1 * PH + hh) * PNK * 128, rs, r32, hi, t2);
        if (hi == 0) {
#pragma unroll
            for (int j = 0; j < 16; ++j) { scr[j * 32 + r32] = t1[j]; scr[(16 + j) * 32 + r32] = t2[j]; }
        }
        float c[16];
        {
            constexpr int NC = 50;
#pragma unroll
            for (int blk = 0; blk < 4; ++blk) {
                float cb[16];
#pragma unroll
                for (int q = 0; q < 16; ++q) {
                    const int idx = 16 * blk + q;
                    int cnt2 = 0, fa = -1, fb = -1;
#pragma unroll
                    for (int ia = 0; ia < 16; ++ia)
#pragma unroll
                        for (int ib = 0; ib < 16; ++ib)
                            if ((ia + 1) * (ib + 1) <= 16) { if (cnt2 == idx) { fa = ia; fb = ib; } ++cnt2; }
                    cb[q] = (idx < NC) ? __uint_as_float((__float_as_uint(t1[fa < 0 ? 0 : fa] + t2[fb < 0 ? 0 : fb]) & ~255u) | (unsigned)((fa < 0 ? 0 : fa) * 16 + (fb < 0 ? 0 : fb))) : NEG;
                }
                sort16(cb);
                if (blk == 0) {
#pragma unroll
                    for (int i = 0; i < 16; ++i) c[i] = cb[i];
                } else merge16(c, cb);
            }
        }
        asm volatile("s_waitcnt lgkmcnt(0)" ::: "memory");
        float ev[8]; int ee[8]; float esum = 0.f;
        unsigned hmsk = hi ? 0xffffffffu : 0u; asm volatile("" : "+v"(hmsk));
        const float cmax = __uint_as_float(__float_as_uint(c[0]) & ~255u);
#pragma unroll
        for (int k = 0; k < 8; ++k) {
            const unsigned code = ((__float_as_uint(c[8 + k]) & hmsk) | (__float_as_uint(c[k]) & ~hmsk)) & 255u;
            const unsigned p1 = __float_as_uint(scr[(code >> 4) * 32 + r32]), p2 = __float_as_uint(scr[(16 + (code & 15u)) * 32 + r32]);
            const float v = __uint_as_float(p1 & ~127u) + __uint_as_float(p2 & ~127u);
            ee[k] = (int)((p1 & 127u) * PNK + (p2 & 127u));
            ev[k] = __builtin_amdgcn_exp2f((v - cmax) * LOG2E); esum += ev[k];
        }
        esum += xshfl<32>(esum);
        const float inv = __builtin_amdgcn_rcpf(esum);
#pragma unroll
        for (int k = 0; k < 8; ++k) { const int kk = hh * 16 + 8 * hi + k; skey[tl * 128 + kk] = ((unsigned)ee[k] << 7) | (unsigned)kk; sel_g[tl * 128 + kk] = ev[k] * inv; }
    }
    __syncthreads();
#pragma unroll 1
    for (int tl = wid; tl < 64; tl += NWAVES) {
        unsigned k0 = skey[tl * 128 + lane], k1 = skey[tl * 128 + 64 + lane];
#define BSTAGE(K, J) do { const unsigned o0 = xshfl_u<(J)>(k0), o1 = xshfl_u<(J)>(k1); \
        const bool up0 = ((lane & (K)) == 0), up1 = (((64 + lane) & (K)) == 0), lowl = ((lane & (J)) == 0); \
        k0 = (lowl == up0) ? (k0 < o0 ? k0 : o0) : (k0 > o0 ? k0 : o0); k1 = (lowl == up1) ? (k1 < o1 ? k1 : o1) : (k1 > o1 ? k1 : o1); } while (0)
        BSTAGE(2, 1);
        BSTAGE(4, 2); BSTAGE(4, 1);
        BSTAGE(8, 4); BSTAGE(8, 2); BSTAGE(8, 1);
        BSTAGE(16, 8); BSTAGE(16, 4); BSTAGE(16, 2); BSTAGE(16, 1);
        BSTAGE(32, 16); BSTAGE(32, 8); BSTAGE(32, 4); BSTAGE(32, 2); BSTAGE(32, 1);
        BSTAGE(64, 32); BSTAGE(64, 16); BSTAGE(64, 8); BSTAGE(64, 4); BSTAGE(64, 2); BSTAGE(64, 1);
        { const unsigned lo = k0 < k1 ? k0 : k1, hi2 = k0 < k1 ? k1 : k0; k0 = lo; k1 = hi2; }
        BSTAGE(128, 32); BSTAGE(128, 16); BSTAGE(128, 8); BSTAGE(128, 4); BSTAGE(128, 2); BSTAGE(128, 1);
#undef BSTAGE
        skey[tl * 128 + lane] = k0; skey[tl * 128 + 64 + lane] = k1;
    }
    asm volatile("s_waitcnt lgkmcnt(0)" ::: "memory");
#define KEY_AT(K0, K1, q) ((q) < 64 ? (unsigned)__builtin_amdgcn_readlane((int)(K0), (q)) : (unsigned)__builtin_amdgcn_readlane((int)(K1), (q) - 64))
#define WCOUNT(K0, K1, w) (__builtin_popcountll(__ballot((int)((K0) >> WSHIFT) == (w))) + __builtin_popcountll(__ballot((int)((K1) >> WSHIFT) == (w))))
#ifndef PEER_DUP_U
#define PEER_DUP_U 1
#endif
#pragma unroll 1
    for (int hf = 0; hf < 2 * PEER_DUP_U; ++hf) {
        int tidu = threadIdx.x; asm volatile("" : "+v"(tidu));
        const int lane = tidu & 63, wid = tidu >> 6, hv = hf & 1;
        if (hv == 0) {
#pragma unroll
            for (int g = 0; g < 8; ++g) { abuf[(wid + 8 * g) * 128 + lane] = 0.f; abuf[(wid + 8 * g) * 128 + 64 + lane] = 0.f; }
        }
        unsigned xh[8][4], xl[8][4];
#pragma unroll
        for (int g = 0; g < 8; ++g) {
            const int tl = wid + 8 * g;
            const bf16_t* xr = x2b + (tok0 + tl) * DM + lane * 4;
            float mx = 0.f;
#pragma unroll
            for (int i = 0; i < 16; ++i) { const uint2 t2 = *reinterpret_cast<const uint2*>(xr + 256 * i);
                mx = fmaxf(mx, fmaxf(fmaxf(fabsf(bf_lo(t2.x)), fabsf(bf_hi(t2.x))), fmaxf(fabsf(bf_lo(t2.y)), fabsf(bf_hi(t2.y))))); }
            mx = wave_max(mx);
            mx = fmaxf(mx, 1e-30f);
            const float inv = 127.0f / mx;
            if (lane == 0) sxl[tl] = mx * (1.0f / 127.0f);
            asm volatile("" ::: "memory");
            const bf16_t* xq = xr + 2048 * hv;
#pragma unroll
            for (int d = 0; d < 4; ++d) {
                unsigned wh = 0, wl = 0;
#pragma unroll
                for (int hh2 = 0; hh2 < 2; ++hh2) {
                    const uint2 t2 = *reinterpret_cast<const uint2*>(xq + 256 * (2 * d + hh2));
                    const float xv[4] = {bf_lo(t2.x), bf_hi(t2.x), bf_lo(t2.y), bf_hi(t2.y)};
#pragma unroll
                    for (int c = 0; c < 4; ++c) {
                        const int j = 4 * hh2 + c;
                        const unsigned u8 = (unsigned)((int)rintf(xv[c] * inv) + 128);
                        wh |= (((u8 >> 4) ^ 8u) & 15u) << (4 * j); wl |= ((u8 & 15u) ^ 8u) << (4 * j);
                    }
                }
                xh[g][d] = wh; xl[g][d] = wl;
            }
            asm volatile("" ::: "memory"); __builtin_amdgcn_sched_barrier(0);
        }
        u32x4 rr[16];
#define U_LOAD(J, G2, C2) do { const int tl_ = wid + 8 * (G2); \
            const unsigned key_ = (unsigned)__builtin_amdgcn_readfirstlane((int)skey[tl_ * 128 + 16 * (C2) + (J)]); \
            const unsigned char* up_ = ub + (size_t)(key_ >> 7) * V4ROW + lane * 16 + hv * 1024; \
            rr[J] = *reinterpret_cast<const u32x4*>(up_); } while (0)
#pragma unroll
        for (int j = 0; j < 16; ++j) U_LOAD(j, 0, 0);
#pragma unroll 1
        for (int c = 0; c < 8; ++c) {
            if (rdv && hf < 2 && (c & 1) == 0) xcc_rendezvous(gbar, rcnt + hf * 4 + (c >> 1));
            const int cn = c + 1 < 8 ? c + 1 : 7;
#pragma unroll
            for (int g = 0; g < 8; ++g) {
                const int tl = wid + 8 * g;
#pragma unroll
                for (int jj = 0; jj < 2; ++jj) {
                    float sr[8];
#pragma unroll
                    for (int j = 0; j < 8; ++j) {
                        int ah = 0, al = 0;
#pragma unroll
                        for (int d = 0; d < 4; ++d) { const int wv = (int)rr[8 * jj + j][d];
                            ah = __builtin_amdgcn_sdot8(wv, (int)xh[g][d], ah, false); al = __builtin_amdgcn_sdot8(wv, (int)xl[g][d], al, false); }
                        sr[j] = (float)(16 * ah + al);
                        if (g + 1 < 8) U_LOAD(8 * jj + j, (g + 1 < 8 ? g + 1 : 0), c); else U_LOAD(8 * jj + j, 0, cn);
                        __builtin_amdgcn_sched_barrier(0);
                    }
                    {
                        const bool b0 = lane & 1, b1 = lane & 2, b2 = lane & 4;
                        float t4[4], t2[2], t1;
#pragma unroll
                        for (int j = 0; j < 4; ++j) { const float keep = b0 ? sr[2 * j + 1] : sr[2 * j], give = b0 ? sr[2 * j] : sr[2 * j + 1]; t4[j] = keep + xshfl<1>(give); }
#pragma unroll
                        for (int j = 0; j < 2; ++j) { const float keep = b1 ? t4[2 * j + 1] : t4[2 * j], give = b1 ? t4[2 * j] : t4[2 * j + 1]; t2[j] = keep + xshfl<2>(give); }
                        { const float keep = b2 ? t2[1] : t2[0], give = b2 ? t2[0] : t2[1]; t1 = keep + xshfl<4>(give); }
                        t1 += xshfl<8>(t1); t1 += xshfl<16>(t1); t1 += xshfl<32>(t1);
                        if (lane < 8) abuf[tl * 128 + 16 * c + 8 * jj + lane] += t1;
                    }
                }
            }
        }
#undef U_LOAD
    }
    asm volatile("s_waitcnt lgkmcnt(0)" ::: "memory");
#pragma unroll 1
    for (int tl = wid; tl < 64; tl += NWAVES) {
        const float rs = r2[tl];
#pragma unroll
        for (int r = 0; r < 2; ++r) {
            const unsigned key = skey[tl * 128 + 64 * r + lane]; const int e = (int)(key >> 7), kk = (int)(key & 127u);
            const float av = (abuf[tl * 128 + 64 * r + lane] + 8.0f * rsum[e]) * (rs * sxl[tl]) * su[e];
            abuf[tl * 128 + 64 * r + lane] = sel_g[tl * 128 + kk] * gelu_tanh(av) * sv[e];
        }
    }
    asm volatile("s_waitcnt lgkmcnt(0)" ::: "memory");
    typedef _Float16 h2_t __attribute__((ext_vector_type(2)));
#pragma unroll 1
    for (int rnd = 0; rnd < 2; ++rnd) {
        int tidv = threadIdx.x; asm volatile("" : "+v"(tidv));
        const int lane = tidv & 63, wid = tidv >> 6;
        h2_t y[4][32];
#pragma unroll
        for (int g = 0; g < 4; ++g) {
            const int tl = wid + 8 * (4 * rnd + g);
#pragma unroll
            for (int i = 0; i < 32; ++i) y[g][i] = (h2_t){(_Float16)0.f, (_Float16)0.f};
        }
        u32x4 rr[8][2];
#define V_LOAD(J, G2, C2) do { const int tl_ = wid + 8 * (4 * rnd + (G2)); \
            const unsigned key_ = (unsigned)__builtin_amdgcn_readfirstlane((int)skey[tl_ * 128 + 8 * (C2) + (J)]); \
            const unsigned char* vp_ = vb + (size_t)(key_ >> 7) * V4ROW + lane * 16; \
            rr[J][0] = *reinterpret_cast<const u32x4*>(vp_); rr[J][1] = *reinterpret_cast<const u32x4*>(vp_ + 1024); } while (0)
#pragma unroll
        for (int j = 0; j < 8; ++j) V_LOAD(j, 0, 0);
#pragma unroll 1
        for (int c = 0; c < 16; ++c) {
            const int cn = c + 1 < 16 ? c + 1 : 15;
#pragma unroll
            for (int g = 0; g < 4; ++g) {
#pragma unroll
                for (int j = 0; j < 8; ++j) {
                    const _Float16 wh = (_Float16)abuf[(wid + 8 * (4 * rnd + g)) * 128 + 8 * c + j]; const h2_t w2 = {wh, wh};
#pragma unroll
                    for (int d = 0; d < 8; ++d) {
                        const int wv = (int)rr[j][d >> 2][d & 3];
                        y[g][4 * d + 0] = __builtin_elementwise_fma(__builtin_bit_cast(h2_t, __builtin_amdgcn_cvt_scalef32_pk_f16_fp4(wv, 1.0f, 0)), w2, y[g][4 * d + 0]);
                        y[g][4 * d + 1] = __builtin_elementwise_fma(__builtin_bit_cast(h2_t, __builtin_amdgcn_cvt_scalef32_pk_f16_fp4(wv, 1.0f, 1)), w2, y[g][4 * d + 1]);
                        y[g][4 * d + 2] = __builtin_elementwise_fma(__builtin_bit_cast(h2_t, __builtin_amdgcn_cvt_scalef32_pk_f16_fp4(wv, 1.0f, 2)), w2, y[g][4 * d + 2]);
                        y[g][4 * d + 3] = __builtin_elementwise_fma(__builtin_bit_cast(h2_t, __builtin_amdgcn_cvt_scalef32_pk_f16_fp4(wv, 1.0f, 3)), w2, y[g][4 * d + 3]);
                    }
                    if (g + 1 < 4) V_LOAD(j, (g + 1 < 4 ? g + 1 : 0), c); else V_LOAD(j, 0, cn);
                    __builtin_amdgcn_sched_barrier(0);
                }
            }
        }
#undef V_LOAD
#pragma unroll
        for (int g = 0; g < 4; ++g) {
            const size_t tok = tok0 + wid + 8 * (4 * rnd + g);
            const bf16_t* ip = x2b + tok * DM + lane * 4; float* op = outw + tok * DM + lane * 4;
#pragma unroll
            for (int i = 0; i < 16; ++i) {
                const uint2 xw = *reinterpret_cast<const uint2*>(ip + 256 * i);
                f32x4 p;
                p[0] = bf_lo(xw.x) + (float)y[g][2 * i].x; p[1] = bf_hi(xw.x) + (float)y[g][2 * i].y; p[2] = bf_lo(xw.y) + (float)y[g][2 * i + 1].x; p[3] = bf_hi(xw.y) + (float)y[g][2 * i + 1].y;
                __builtin_nontemporal_store(p, reinterpret_cast<f32x4*>(op + 256 * i));
            }
        }
    }
#undef KEY_AT
#undef WCOUNT
}
}

constexpr int N_PHASES = 7;
#ifndef MK_N_LAUNCHES
#define MK_N_LAUNCHES 1
#endif
__global__ void __launch_bounds__(NTHREADS, 2) mk_fwd(Args args) {
    extern __shared__ __attribute__((aligned(16))) unsigned char lds[];
    const int tid = threadIdx.x;
    unsigned char* ws = args.ws; unsigned char* sm = ws + WS_SMALL;
    unsigned* ctl = (unsigned*)(ws + WS_CTL);
    volatile LAS unsigned* misc = (volatile LAS unsigned*)((LAS unsigned char*)lds + LDS_MISC);
    if (tid < 16) misc[tid] = 0u;
    __syncthreads();
    const int lo = args.ph_lo, hi = args.ph_hi;
    const bool multi = (hi - lo) > 1;
    XcdBarrier bar; bar.bar = ctl + CW_BAR; bar.x = 0; bar.st = misc;
    if (multi) bar = xcd_barrier_post(ctl + CW_BAR, misc);
#ifndef PH_MASK
#define PH_MASK 0x7f
#endif
#define IN(k) (((PH_MASK >> (k)) & 1) && lo <= (k) && (k) < hi)
#define SEAM(k) do { if (IN(k) && IN((k) + 1)) xcd_barrier(bar); } while (0)
#ifndef DUP_MASK
#define DUP_MASK 0
#endif
#define DUP(k) (((DUP_MASK >> (k)) & 1) != 0)

#ifndef TABLES_LATE
#define TABLES_LATE 0
#endif

    if (IN(0)) { p0_prologue(args, (char*)lds);
#if !TABLES_LATE && !TABLES_IN_P2
        p0_tables(args);
#endif
 if (DUP(0)) { xcd_barrier(bar); p0_prologue(args, (char*)lds); p0_tables(args); } SEAM(0); }

    if (IN(1)) {
        pg8::Gemm g{(const bf16_t*)(ws + WS_XB), (const bf16_t*)(ws + WS_WIN), TOK, NIN, DM};
        pg8::StaticOrder S; S.init(TOK, NIN, (int)gridDim.x, (int)blockIdx.x);
        pg8::EpiProj E{(bf16_t*)(ws + WS_Q), (size_t)(WS_K - WS_Q) / 2, (const float*)(sm + SM_RSTD1), args.in[3], args.in[4], (LAS float*)((LAS unsigned char*)lds + LDS_XCH)};
        pg8::gemm_phase<pg8::EpiProj, pg8::StaticOrder, false>((LAS unsigned char*)lds, g, S, E, nullptr);
        if (DUP(1)) { xcd_barrier(bar); pg8::gemm_phase<pg8::EpiProj, pg8::StaticOrder, false>((LAS unsigned char*)lds, g, S, E, nullptr); }
        SEAM(1);
    }

    if (IN(2)) {
#ifndef DUP_REC
#define DUP_REC 0
#endif
#ifndef DUP_ATT
#define DUP_ATT 0
#endif
#pragma unroll 1
        for (int rep = 0; rep < 1 + DUP_REC; ++rep) {
            if (rep) xcd_barrier(bar);
            for (;;) {
                __syncthreads();
                if (tid == 0) misc[4] = __hip_atomic_fetch_add(ctl + CW_QUEUE + 256 * rep, 1u, RLX_AGENT);
                __syncthreads();
                const int item = (int)misc[4];
                if (item >= 64) break;
                rec::rec_chain((const bf16_t*)(ws + WS_XR), (const bf16_t*)(ws + WS_GY), args.in[6], args.in[7], (const bf16_t*)(sm + SM_WGT), args.in[9], args.in[11], args.in[12],
                               (bf16_t*)(ws + WS_MIX), (float*)(sm + SM_RSSQ), item >> 4, item & 15, (char*)lds);
            }
        }
#pragma unroll 1
        for (int rep = 0; rep < 1 + DUP_ATT; ++rep) {
            if (rep) xcd_barrier(bar);
#if TABLES_IN_P2
            {
                constexpr int NAUX = TBL_ITEMS + TR_ITEMS, NTOT = 1024 + NAUX;
                static_assert(NAUX * 27 == NTOT * 11, "interleave ratio");
                for (;;) {
                    __syncthreads();
                    if (tid == 0) misc[4] = __hip_atomic_fetch_add(ctl + CW_QUEUE + 64 + 256 * rep, 1u, RLX_AGENT);
                    __syncthreads();
                    const int qi = (int)misc[4];
                    if (qi >= NTOT) break;
                    const int ab = qi * 11 / 27, aa = (qi + 1) * 11 / 27;
                    if (aa > ab) {
                        if (ab < TBL_ITEMS) p0_tables_item(args, ab);
                        else transpose_seq<false>(args, (char*)lds, (ab - TBL_ITEMS) * TR_ITEM_TILES, 1, (ab - TBL_ITEMS + 1) * TR_ITEM_TILES);
                        continue;
                    }
                    const int u = qi - ab;
                    const int g = 15 - (u >> 6), bh = u & 63;
                    att::attn_unit((const bf16_t*)(ws + WS_Q), (const bf16_t*)(ws + WS_K), (const bf16_t*)(ws + WS_V), args.in[5], (bf16_t*)(ws + WS_MIX), (float*)(sm + SM_ASSQ), bh >> 4, bh & 15, g, (char*)lds);
                }
            }
#else
            for (;;) {
                __syncthreads();
                if (tid == 0) misc[4] = __hip_atomic_fetch_add(ctl + CW_QUEUE + 64 + 256 * rep, 1u, RLX_AGENT);
                __syncthreads();
                const int u = (int)misc[4];
                if (u >= 1024) break;
                const int g = 15 - (u >> 6), bh = u & 63;
                att::attn_unit((const bf16_t*)(ws + WS_Q), (const bf16_t*)(ws + WS_K), (const bf16_t*)(ws + WS_V), args.in[5], (bf16_t*)(ws + WS_MIX), (float*)(sm + SM_ASSQ), bh >> 4, bh & 15, g, (char*)lds);
            }
#endif
        }
        SEAM(2);
    }


    if (IN(4)) {
        pg8::Gemm g{(const bf16_t*)(ws + WS_MIX), (const bf16_t*)(ws + WS_WOUT), TOK, DM, DM / 2};
        pg8::StaticOrder S; S.init(TOK, DM, (int)gridDim.x, (int)blockIdx.x);
        LAS float* rs = (LAS float*)((LAS unsigned char*)lds + LDS_XCH);
        {
            const float* assq = (const float*)(sm + SM_ASSQ); const float* rssq = (const float*)(sm + SM_RSSQ);
            if (tid < 256) {
                for (int i = 0; i < 4; ++i) { pg8::Unit u; if (!S.next(i, u)) break;
                    const size_t row = (size_t)u.pm * 256 + tid; float sa = 0.f, sr = 0.f;
#pragma unroll
                    for (int j = 0; j < 4; ++j) { const f32x4 pa = *reinterpret_cast<const f32x4*>(assq + row * 16 + 4 * j), pr = *reinterpret_cast<const f32x4*>(rssq + row * 16 + 4 * j);
                        sa += (pa[0] + pa[1]) + (pa[2] + pa[3]); sr += (pr[0] + pr[1]) + (pr[2] + pr[3]); }
                    const float ra = __builtin_amdgcn_rsqf(sa * (1.0f / DATT) + EPS), rr = __builtin_amdgcn_rsqf(sr * (1.0f / DREC) + EPS);
                    const float ra8 = ra * (1.0f / (W8S * MIX_SA)), rr8 = rr * (1.0f / (W8S * MIX_SR));
                    rs[i * 512 + tid] = ra8 / rr8; rs[i * 512 + 256 + tid] = rr8; }
            }
            __syncthreads();
        }
        pg8::EpiOut E{args.in[0], args.out, (bf16_t*)(ws + WS_XB), (float*)(sm + SM_SSQ2), rs, 0};
        pg8::gemm_phase<pg8::EpiOut, pg8::StaticOrder, false, true>((LAS unsigned char*)lds, g, S, E, nullptr);
        if (DUP(4)) { xcd_barrier(bar); pg8::gemm_phase<pg8::EpiOut, pg8::StaticOrder, false, true>((LAS unsigned char*)lds, g, S, E, nullptr); }
        SEAM(4);
    }

    if (IN(5)) {
        pg8::Gemm g{(const bf16_t*)(ws + WS_XB), (const bf16_t*)(ws + WS_WPQ), TOK, PQN, DM};
        pg8::StaticOrder S; S.init(TOK, PQN, (int)gridDim.x, (int)blockIdx.x);
        pg8::EpiPq E{(bf16_t*)(ws + WS_Q)};
        pg8::gemm_phase<pg8::EpiPq, pg8::StaticOrder, false>((LAS unsigned char*)lds, g, S, E, nullptr);
        if (DUP(5)) { xcd_barrier(bar); pg8::gemm_phase<pg8::EpiPq, pg8::StaticOrder, false>((LAS unsigned char*)lds, g, S, E, nullptr); }
        SEAM(5);
    }

    if (IN(6)) {
#if TABLES_LATE
        p0_tables(args); if (multi) xcd_barrier(bar);
#endif
        const bool one_each = multi && (int)gridDim.x == TOK / 64;
        for (int u = blockIdx.x; u < TOK / 64; u += gridDim.x) peer::peer_unit(args, u, (char*)lds, args.out, bar, ctl + CW_XCNT, one_each);
        if (DUP(6)) { xcd_barrier(bar); for (int u = blockIdx.x; u < TOK / 64; u += gridDim.x) peer::peer_unit(args, u, (char*)lds, (float*)(ws + WS_V), bar, ctl + CW_XCNT, false); }
    }
#undef IN
#undef SEAM
}

extern "C" void kernel_launch(void* const* d_in, const int* in_sizes, int n_in, void* d_out, int out_size, void* d_ws, size_t ws_size, hipStream_t stream) {
    static int grid = 0;
    if (grid == 0) {
        if (n_in != 22 || in_sizes[0] != TOK * DM || out_size != TOK * DM || ws_size < WS_END) {
            fprintf(stderr, "kernel_launch: built for 22 inputs, x/out of %d floats, >= %zu bytes of workspace; got n_in %d, in0 %d, out %d, ws %zu; nothing launched\n", TOK * DM, (size_t)WS_END, n_in, n_in > 0 ? in_sizes[0] : -1, out_size, ws_size);
            grid = -1; return; }
        int dev = 0, cus = 0, per_cu = 0;
        if (hipGetDevice(&dev) != hipSuccess || hipDeviceGetAttribute(&cus, hipDeviceAttributeMultiprocessorCount, dev) != hipSuccess) { fprintf(stderr, "kernel_launch: device query failed\n"); grid = -1; return; }
        if (hipFuncSetAttribute((const void*)mk_fwd, hipFuncAttributeMaxDynamicSharedMemorySize, LDS_BYTES) != hipSuccess) { fprintf(stderr, "kernel_launch: hipFuncSetAttribute failed\n"); grid = -1; return; }
        if (hipOccupancyMaxActiveBlocksPerMultiprocessor(&per_cu, (const void*)mk_fwd, NTHREADS, LDS_BYTES) != hipSuccess || per_cu < 1)
            fprintf(stderr, "kernel_launch: note: occupancy query reports %d workgroups per CU\n", per_cu);
        (void)hipGetLastError();
        grid = cus;
    }
    if (grid < 0) return;
    if (hipMemsetAsync((char*)d_ws + WS_CTL, 0, CTL_BYTES, stream) != hipSuccess) { fprintf(stderr, "kernel_launch: memset failed\n"); return; }
    Args a{};
    for (int i = 0; i < 22; ++i) a.in[i] = (const float*)d_in[i];
    a.out = (float*)d_out; a.ws = (unsigned char*)d_ws;
#if MK_N_LAUNCHES == 1
    a.ph_lo = 0; a.ph_hi = N_PHASES;
    hipLaunchKernelGGL(mk_fwd, dim3(grid), dim3(NTHREADS), LDS_BYTES, stream, a);
#else
    for (int p = 0; p < N_PHASES; ++p) { a.ph_lo = p; a.ph_hi = p + 1; hipLaunchKernelGGL(mk_fwd, dim3(grid), dim3(NTHREADS), LDS_BYTES, stream, a); }
#endif
    const hipError_t le = hipPeekAtLastError();
    if (le != hipSuccess) fprintf(stderr, "kernel_launch: launch failed: %s\n", hipGetErrorName(le));
}
```

```cpp
#include <hip/hip_runtime.h>
#include <cstdio>
#include <cstdint>

#define LAS __attribute__((address_space(3)))
#define RLX_AGENT __ATOMIC_RELAXED, __HIP_MEMORY_SCOPE_AGENT

constexpr int BATCH = 4, SEQ = 4096, TOK = BATCH * SEQ, DM = 4096, DATT = 2048, DREC = 2048, NIN = 10240, NHEAD = 16, HD = 128, CHUNK = 64, NREL = 513;
constexpr int NRB = 16, RBD = 128, PH = 8, PNK = 128, PQD = 256, PTOPK = 16, PQN = PH * PQD  , NEXP = 16384;
constexpr float EPS = 1e-6f, LOG2E = 1.4426950408889634f;

constexpr size_t MB = 1024ull * 1024ull;
constexpr size_t WS_CTL = 0;
constexpr size_t CTL_BYTES = 64 * 1024;
constexpr size_t WS_PROG = WS_CTL + CTL_BYTES;
constexpr size_t PROG_BYTES = 16 * 256 * 4;
constexpr size_t WS_SMALL = WS_PROG + 64 * 1024;
constexpr size_t SM_RSTD1 = 0;
constexpr size_t SM_ASSQ = SM_RSTD1 + (size_t)TOK * 4;
constexpr size_t SM_RSSQ = SM_ASSQ + (size_t)TOK * 16 * 4;
constexpr size_t SM_SSQ2 = SM_RSSQ + (size_t)TOK * 16 * 4;
constexpr size_t SM_WGT = SM_SSQ2 + (size_t)TOK * 64 * 4;
constexpr size_t SM_KEYS = SM_WGT + (size_t)16 * 2 * 128 * 128 * 2;
constexpr size_t SM_SU = SM_KEYS + (size_t)2 * 8 * 128 * 128 * 2;
constexpr size_t SM_SV = SM_SU + (size_t)16384 * 4;
constexpr size_t SM_RSUM = SM_SV + (size_t)16384 * 4;
constexpr size_t SM_END = SM_RSUM + (size_t)16384 * 4;
constexpr size_t WS_XB = WS_SMALL + 8 * MB;
constexpr size_t WS_WIN = WS_XB + 128 * MB;
constexpr size_t WS_WOUT = WS_WIN + 80 * MB;
constexpr size_t WS_WPQ = WS_WOUT + 32 * MB;
constexpr size_t WS_UB = WS_WPQ + 16 * MB;
constexpr size_t WS_VB = WS_UB + 128 * MB;
constexpr size_t WS_Q = WS_VB + 128 * MB;
constexpr size_t WS_K = WS_Q + 64 * MB;
constexpr size_t WS_V = WS_K + 64 * MB;
constexpr size_t WS_XR = WS_V + 64 * MB;
constexpr size_t WS_GY = WS_XR + 64 * MB;
constexpr size_t WS_MIX = WS_GY + 64 * MB;
constexpr size_t WS_END = WS_MIX + 128 * MB;
static_assert(SM_END <= 8 * MB, "small region");

constexpr int CW_BAR = 0;
constexpr int CW_QUEUE = 4096;
constexpr int CW_TMO = 4160;
constexpr int CW_XCNT = 4224;

constexpr int NWAVES = 8, NTHREADS = 512;
constexpr int LDS_BYTES = 147456;
constexpr int LDS_XCH = 131072;
constexpr int LDS_MISC = 143360;

typedef unsigned short bf16_t;
typedef short bf16x8 __attribute__((ext_vector_type(8)));
typedef short s16x4 __attribute__((ext_vector_type(4)));
typedef float f32x4 __attribute__((ext_vector_type(4)));
typedef float f32x16 __attribute__((ext_vector_type(16)));
typedef unsigned u32x4 __attribute__((ext_vector_type(4)));
typedef __attribute__((ext_vector_type(2))) __bf16 bf16x2_t;
typedef unsigned u32x6 __attribute__((ext_vector_type(6)));
typedef unsigned u32x16 __attribute__((ext_vector_type(16)));
typedef float f32x32 __attribute__((ext_vector_type(32)));
constexpr int V4ROW = 2048;
constexpr int V6ROW = 3072;
#ifndef FP6_INTERLEAVED
#define FP6_INTERLEAVED 1
#endif
__host__ __device__ constexpr int fp6_feat(int j) { return FP6_INTERLEAVED ? ((j >> 1) + 16 * (j & 1)) : j; }

constexpr float W8S = 64.0f, MIX_SA = 16.0f, MIX_SR = 4.0f;
__device__ __forceinline__ unsigned cvt4_fp8(float a, float b, float c, float d) { int w = 0; w = __builtin_amdgcn_cvt_pk_fp8_f32(a, b, w, false); w = __builtin_amdgcn_cvt_pk_fp8_f32(c, d, w, true); return (unsigned)w; }
__device__ __forceinline__ unsigned cvtpk(float lo, float hi) { unsigned r; asm volatile("v_cvt_pk_bf16_f32 %0, %1, %2" : "=v"(r) : "v"(lo), "v"(hi)); return r; }
__device__ __forceinline__ float bf_lo(unsigned w) { return __uint_as_float(w << 16); }
__device__ __forceinline__ float bf_hi(unsigned w) { return __uint_as_float(w & 0xffff0000u); }
__device__ __forceinline__ float bf2f(bf16_t b) { return __uint_as_float(((unsigned)b) << 16); }
template <int K> __device__ __forceinline__ unsigned xshfl_u(unsigned v) {
    if constexpr (K == 1) return (unsigned)__builtin_amdgcn_update_dpp(0, (int)v, 0xB1, 0xf, 0xf, true);
    else if constexpr (K == 2) return (unsigned)__builtin_amdgcn_update_dpp(0, (int)v, 0x4E, 0xf, 0xf, true);
    else if constexpr (K == 4 || K == 8 || K == 16) return (unsigned)__builtin_amdgcn_ds_swizzle((int)v, (K << 10) | 0x1F);
    else { static_assert(K == 32, "xshfl: K");
        const auto r = __builtin_amdgcn_permlane32_swap(v, v, false, false);
        return (threadIdx.x & 32) ? r[0] : r[1]; }
}
template <int K> __device__ __forceinline__ float xshfl(float v) { return __uint_as_float(xshfl_u<K>(__float_as_uint(v))); }
__device__ __forceinline__ float wave_sum(float v) {
    v += xshfl<1>(v); v += xshfl<2>(v); v += xshfl<4>(v); v += xshfl<8>(v); v += xshfl<16>(v);
    { const auto r = __builtin_amdgcn_permlane32_swap(__float_as_uint(v), __float_as_uint(v), false, false); v = __uint_as_float(r[0]) + __uint_as_float(r[1]); }
    return v;
}
__device__ __forceinline__ float wave_max(float v) {
    v = fmaxf(v, xshfl<1>(v)); v = fmaxf(v, xshfl<2>(v)); v = fmaxf(v, xshfl<4>(v)); v = fmaxf(v, xshfl<8>(v)); v = fmaxf(v, xshfl<16>(v));
    { const auto r = __builtin_amdgcn_permlane32_swap(__float_as_uint(v), __float_as_uint(v), false, false); v = fmaxf(__uint_as_float(r[0]), __uint_as_float(r[1])); }
    return v;
}
__device__ __forceinline__ float dot2bf(unsigned a, unsigned b, float acc) { return __builtin_amdgcn_fdot2_f32_bf16(__builtin_bit_cast(bf16x2_t, a), __builtin_bit_cast(bf16x2_t, b), acc, false); }
__device__ __forceinline__ float gelu_tanh(float x) {
    const float z = x * (0.7978845608028654f + 0.035677408136300125f * x * x);
    const float e = __builtin_amdgcn_exp2f(-2.0f * LOG2E * z);
    return x * __builtin_amdgcn_rcpf(1.0f + e);
}
__device__ __forceinline__ float sigmoid_f(float x) { return __builtin_amdgcn_rcpf(1.0f + __builtin_amdgcn_exp2f(-LOG2E * x)); }

#define XB_TMO      128
#define XB_XCNT(j)  (256  + 64 * (j))
#define XB_XSUB(j)  (1280 + 64 * (j))
#define XB_XGEN(j)  (2304 + 64 * (j))
#define XB_TOP      3328
#define XB_TOPGEN   3392
#define XCD_BAR_WORDS 3456
#define XB_SPIN_CAP (1u << 18)

__device__ __forceinline__ unsigned xb_ld(unsigned* p)              { return __hip_atomic_load(p, __ATOMIC_RELAXED, __HIP_MEMORY_SCOPE_AGENT); }
__device__ __forceinline__ unsigned xb_add(unsigned* p, unsigned v) { return __hip_atomic_fetch_add(p, v, __ATOMIC_RELAXED, __HIP_MEMORY_SCOPE_AGENT); }
__device__ __forceinline__ unsigned xb_xcc_id() { return (unsigned)__builtin_amdgcn_s_getreg((3 << 11) | 20) & 0xFu; }
#define XB_SPIN(cond, bar) do { unsigned _sp = 0; while (cond) { __builtin_amdgcn_s_sleep(1); \
    if ((++_sp & 255u) == 0u) { if (xb_ld(&(bar)[XB_TMO])) break; if (_sp > XB_SPIN_CAP) { atomicAdd(&(bar)[XB_TMO], 1u); break; } } } } while (0)

struct XcdBarrier {
    unsigned* bar; unsigned x;
    volatile LAS unsigned* st;
};

__device__ __forceinline__ XcdBarrier xcd_barrier_post(unsigned* bar, volatile LAS unsigned* st) {
    XcdBarrier b; b.bar = bar; b.x = xb_xcc_id(); b.st = st;
    if (threadIdx.x == 0) (void)xb_add(&bar[XB_XCNT(b.x)], 1u);
    return b;
}
__device__ __forceinline__ void xcd_barrier_complete(unsigned* bar, unsigned x, unsigned& nloc, unsigned& nx) {
    const unsigned G = gridDim.x * gridDim.y * gridDim.z;
    unsigned sum, cnt, mine, sp = 0u;
    for (;;) {
        sum = 0u; cnt = 0u; mine = 0u;
#pragma unroll
        for (unsigned j = 0; j < 16; ++j) { const unsigned c = xb_ld(&bar[XB_XCNT(j)]); sum += c; cnt += (c > 0u) ? 1u : 0u; mine = (j == x) ? c : mine; }
        if (sum == G) break;
        __builtin_amdgcn_s_sleep(1);
        if ((++sp & 255u) == 0u) { if (xb_ld(&bar[XB_TMO])) break; if (sp > XB_SPIN_CAP) { atomicAdd(&bar[XB_TMO], 1u); break; } }
    }
    nloc = mine > 0u ? mine : 1u; nx = cnt > 0u ? cnt : 1u;
}

__device__ __forceinline__ void xcd_barrier(const XcdBarrier& b) {
    asm volatile("s_waitcnt vmcnt(0)" ::: "memory");
    __syncthreads();
    if (threadIdx.x == 0) {
        unsigned* bar = b.bar;
        __builtin_amdgcn_s_waitcnt(0);
        unsigned nloc = b.st[0], nx = b.st[1];
        if (nloc == 0u) { xcd_barrier_complete(bar, b.x, nloc, nx); b.st[0] = nloc; b.st[1] = nx; }
        const unsigned old = xb_add(&bar[XB_XSUB(b.x)], 1u);
        const unsigned gen = old / nloc;
        if (old + 1u == (gen + 1u) * nloc) {
            __builtin_amdgcn_fence(__ATOMIC_RELEASE, "agent");
            asm volatile("s_waitcnt vmcnt(0)" ::: "memory");
            const unsigned og = xb_add(&bar[XB_TOP], 1u);
            const unsigned tg = og / nx;
            if (og + 1u == (tg + 1u) * nx) xb_add(&bar[XB_TOPGEN], 1u);
            else XB_SPIN(xb_ld(&bar[XB_TOPGEN]) == tg, bar);
            __builtin_amdgcn_fence(__ATOMIC_ACQUIRE, "agent");
            xb_add(&bar[XB_XGEN(b.x)], 1u);
            asm volatile("s_waitcnt vmcnt(0)" ::: "memory");
        } else {
            XB_SPIN(xb_ld(&bar[XB_XGEN(b.x)]) == gen, bar);
            __builtin_amdgcn_fence(__ATOMIC_ACQUIRE, "agent");
            asm volatile("s_waitcnt vmcnt(0)" ::: "memory");
        }
    }
    __syncthreads();
}
namespace pg8 {
#define PG8_LAS __attribute__((address_space(3)))
typedef unsigned short bf16_t;
typedef short bf16x8 __attribute__((ext_vector_type(8)));
typedef float f32x4 __attribute__((ext_vector_type(4)));
typedef unsigned u32x4 __attribute__((ext_vector_type(4)));
constexpr int BM = 256, BK = 64, HALF = 128, HTB = HALF * BK * 2  , STAGE_BYTES = 8 * HTB, NXCD = 8, WGM = 8;

__host__ __device__ __forceinline__ int lds_byte(int r, int c) { const int st = (r >> 4) * 2 + (c >> 5), rr = r & 15, cc = c & 31, ob = rr * 64 + cc * 2; return st * 1024 + (ob ^ (((ob >> 9) & 1) << 5)); }
__host__ __device__ __forceinline__ void stage_rc(int b, int& R, int& C) { const int st = b / 1024, sb = b % 1024, swz = sb ^ (((sb >> 9) & 1) << 5); R = (st >> 1) * 16 + swz / 64; C = (st & 1) * 32 + (swz % 64) / 2; }
__host__ __device__ __forceinline__ int perm32(int rho) { const int n = rho >> 4, i = rho & 15; return 8 * (i >> 2) + 4 * n + (i & 3); }

struct Unit { int pm, pn; };
struct Gemm { const bf16_t* A; const bf16_t* Bt; int M, N, K; };

struct StaticOrder {
    int nM, nN, nwg, G, c;
    __host__ __device__ void init(int M, int N, int G_, int c_) { nM = M / BM; nN = N / BM; nwg = nM * nN; G = G_; c = c_; }
    __host__ __device__ __forceinline__ bool next(int i, Unit& u) const {
        const long L = (long)i * G + c; if (L >= nwg) return false;
        int wgid = (int)L; { const int q = nwg / NXCD, r = nwg % NXCD, xcd = wgid % NXCD, off = wgid / NXCD; wgid = (xcd < r ? xcd * (q + 1) : r * (q + 1) + (xcd - r) * q) + off; }
        const int nig = WGM * nN, gid = wgid / nig, fm = gid * WGM, gsz = (nM - fm) < WGM ? (nM - fm) : WGM;
        u.pm = fm + ((wgid % nig) % gsz); u.pn = (wgid % nig) / gsz; return true;
    }
    __device__ __forceinline__ void a_ready(const Unit&) const {}
    __device__ __forceinline__ void done(const Unit&) const {}
};
struct CountedOrder : StaticOrder {
    const unsigned* ready; unsigned need; unsigned* tmo;
    __device__ __forceinline__ void a_ready(const Unit& u) const {
        if (threadIdx.x < 64) {
            const unsigned long long t0 = __builtin_amdgcn_s_memrealtime(); unsigned polls = 0;
            while ((unsigned)__builtin_amdgcn_readfirstlane(__hip_atomic_load(ready + 64 * u.pm, __ATOMIC_RELAXED, __HIP_MEMORY_SCOPE_AGENT)) < need) {
                if ((++polls & 255u) == 0u && __builtin_amdgcn_readfirstlane(__hip_atomic_load(tmo, __ATOMIC_RELAXED, __HIP_MEMORY_SCOPE_AGENT)) != 0u) break;
                if (__builtin_amdgcn_s_memrealtime() - t0 > 2000000ull) {
                    if (threadIdx.x == 0) { unsigned expect = 0u; __hip_atomic_compare_exchange_strong(tmo + 1, &expect, 0x600u | (unsigned)(u.pm & 0xff), __ATOMIC_RELAXED, __ATOMIC_RELAXED, __HIP_MEMORY_SCOPE_AGENT); __hip_atomic_store(tmo, 1u, __ATOMIC_RELAXED, __HIP_MEMORY_SCOPE_AGENT); }
                    break; }
                __builtin_amdgcn_s_sleep(2); }
            __builtin_amdgcn_fence(__ATOMIC_ACQUIRE, "agent");
            asm volatile("s_waitcnt vmcnt(0)" ::: "memory");
        }
#if !defined(BROKEN_HOOK_NO_BARRIER)
        asm volatile("" ::: "memory"); __builtin_amdgcn_s_barrier(); asm volatile("" ::: "memory");
#endif
    }
};

__device__ __forceinline__ unsigned cvt_pk_bf16(float lo, float hi) { unsigned r; asm volatile("v_cvt_pk_bf16_f32 %0, %1, %2" : "=v"(r) : "v"(lo), "v"(hi)); return r; }
typedef float f32x2 __attribute__((ext_vector_type(2)));
__device__ __forceinline__ f32x2 gelu_pk(f32x2 v) {
    const f32x2 av = __builtin_elementwise_abs(v), d = av * 0.2316418882f + 1.0f;
    f32x2 t; t.x = __builtin_amdgcn_rcpf(d.x); t.y = __builtin_amdgcn_rcpf(d.y);
    f32x2 q = t * 0.5307027145f + (-0.7265760135f); q = q * t + 0.7107068705f; q = q * t + (-0.142248368f); q = q * t + 0.127414796f; q = q * t;
    const f32x2 s = (v * v) * (-0.72134752044f);
    f32x2 e; e.x = __builtin_amdgcn_exp2f(s.x); e.y = __builtin_amdgcn_exp2f(s.y);
    const f32x2 m = v * (q * e), r = v - m;
    f32x2 o; o.x = v.x < 0.f ? m.x : r.x; o.y = v.y < 0.f ? m.y : r.y; return o;
}


struct EpiProj {
    static constexpr bool PERM = true, AFTER_DRAIN = false, MIDK = false;
    bf16_t* outq; size_t reg_stride; const float* rstd1; const float* gq; const float* gk; PG8_LAS float* xch;
    __device__ __forceinline__ void operator()(const f32x4 (&acc)[2][2][4][2], const Unit& u, int wr, int wc, int fr, int fq) const {
        const int region = u.pn >> 3, pl = u.pn & 7;
        bf16_t* base = outq + (size_t)region * reg_stride;
        const int row0 = u.pm * BM + wr * 64 + fr;
        const int colL = pl * 256 + wc * 32 + 8 * fq;
        float rsv[2][4];
#pragma unroll
        for (int ai = 0; ai < 2; ++ai)
#pragma unroll
            for (int m = 0; m < 4; ++m) rsv[ai][m] = rstd1[row0 + ai * HALF + m * 16];
        if (region <= 1) {
            const float* g = (region == 0) ? gq : gk;
            const f32x4 g0 = *(const f32x4*)(g + wc * 32 + 8 * fq), g1 = *(const f32x4*)(g + wc * 32 + 8 * fq + 4);
#pragma unroll
            for (int ai = 0; ai < 2; ++ai)
#pragma unroll
                for (int m = 0; m < 4; ++m)
#pragma unroll
                    for (int bj = 0; bj < 2; ++bj) {
                        const f32x4 v0 = acc[ai][bj][m][0], v1 = acc[ai][bj][m][1];
                        float ss = (v0[0] * v0[0] + v0[1] * v0[1]) + (v0[2] * v0[2] + v0[3] * v0[3]) + (v1[0] * v1[0] + v1[1] * v1[1]) + (v1[2] * v1[2] + v1[3] * v1[3]);
                        ss *= rsv[ai][m] * rsv[ai][m];
                        ss += xshfl<16>(ss); ss += xshfl<32>(ss);
                        if (fq == 0) xch[((((wr * 2 + ai) * 4 + m) * 2 + bj) * 16 + fr) * 4 + wc] = ss;
                    }
            asm volatile("s_waitcnt lgkmcnt(0)" ::: "memory"); __builtin_amdgcn_s_barrier(); asm volatile("" ::: "memory");
#pragma unroll
            for (int ai = 0; ai < 2; ++ai)
#pragma unroll
                for (int m = 0; m < 4; ++m) {
                    bf16_t* rowp = base + (size_t)(row0 + ai * HALF + m * 16) * 2048 + colL;
#pragma unroll
                    for (int bj = 0; bj < 2; ++bj) {
                        const f32x4 p = *(const PG8_LAS f32x4*)(xch + ((((wr * 2 + ai) * 4 + m) * 2 + bj) * 16 + fr) * 4);
                        const float rn = __builtin_amdgcn_rsqf(((p[0] + p[1]) + (p[2] + p[3])) * (1.0f / 128.0f) + 1e-6f) * rsv[ai][m];
                        const f32x4 v0 = acc[ai][bj][m][0] * rn * g0, v1 = acc[ai][bj][m][1] * rn * g1;
                        u32x4 w; w.x = cvt_pk_bf16(v0[0], v0[1]); w.y = cvt_pk_bf16(v0[2], v0[3]); w.z = cvt_pk_bf16(v1[0], v1[1]); w.w = cvt_pk_bf16(v1[2], v1[3]);
                        *(u32x4*)(rowp + bj * HALF) = w;
                    }
                }
        } else {
#pragma unroll
            for (int ai = 0; ai < 2; ++ai)
#pragma unroll
                for (int m = 0; m < 4; ++m) {
                    bf16_t* rowp = base + (size_t)(row0 + ai * HALF + m * 16) * 2048 + colL;
                    const float rs = rsv[ai][m];
#pragma unroll
                    for (int bj = 0; bj < 2; ++bj) {
                        f32x4 v0 = acc[ai][bj][m][0] * rs, v1 = acc[ai][bj][m][1] * rs;
                        if (region == 4) {
#pragma unroll
                            for (int j = 0; j < 4; ++j) { v0[j] = gelu_tanh(v0[j]); v1[j] = gelu_tanh(v1[j]); }
                        }
                        u32x4 w; w.x = cvt_pk_bf16(v0[0], v0[1]); w.y = cvt_pk_bf16(v0[2], v0[3]); w.z = cvt_pk_bf16(v1[0], v1[1]); w.w = cvt_pk_bf16(v1[2], v1[3]);
                        *(u32x4*)(rowp + bj * HALF) = w;
                    }
                }
        }
    }
};
struct EpiOut {
    static constexpr bool PERM = true, AFTER_DRAIN = false, MIDK = true;
    const float* x; float* out; bf16_t* x2b; float* ssq2; const PG8_LAS float* rs; mutable int nu;
    __device__ __forceinline__ void midk(f32x4 (&acc)[2][2][4][2], const Unit&, int wr, int, int fr, int) const {
        const PG8_LAS float* t = rs + (nu & 3) * 512;
#pragma unroll
        for (int ai = 0; ai < 2; ++ai)
#pragma unroll
            for (int m = 0; m < 4; ++m) { const float f = t[ai * HALF + wr * 64 + m * 16 + fr];
#pragma unroll
                for (int bj = 0; bj < 2; ++bj)
#pragma unroll
                    for (int n = 0; n < 2; ++n) acc[ai][bj][m][n] = acc[ai][bj][m][n] * f; }
    }
    __device__ __forceinline__ void operator()(const f32x4 (&acc)[2][2][4][2], const Unit& u, int wr, int wc, int fr, int fq) const {
        const int row0 = u.pm * BM + wr * 64 + fr, col0 = u.pn * BM + wc * 32 + 8 * fq;
        const PG8_LAS float* t = rs + (nu & 3) * 512 + 256; ++nu;
#pragma unroll
        for (int ai = 0; ai < 2; ++ai) {
            f32x4 xv[4][2][2];
#pragma unroll
            for (int m = 0; m < 4; ++m)
#pragma unroll
                for (int bj = 0; bj < 2; ++bj) { const size_t o = (size_t)(row0 + ai * HALF + m * 16) * DM + col0 + bj * HALF; const u32x4 xw = *(const u32x4*)(x2b + o);
                    xv[m][bj][0] = (f32x4){bf_lo(xw.x), bf_hi(xw.x), bf_lo(xw.y), bf_hi(xw.y)}; xv[m][bj][1] = (f32x4){bf_lo(xw.z), bf_hi(xw.z), bf_lo(xw.w), bf_hi(xw.w)}; }
#pragma unroll
            for (int m = 0; m < 4; ++m) {
                const size_t row = (size_t)(row0 + ai * HALF + m * 16);
                const float rr = t[ai * HALF + wr * 64 + m * 16 + fr];
                float ss = 0.f;
#pragma unroll
                for (int bj = 0; bj < 2; ++bj) {
                    const size_t o = row * DM + col0 + bj * HALF;
                    const f32x4 v0 = acc[ai][bj][m][0] * rr + xv[m][bj][0], v1 = acc[ai][bj][m][1] * rr + xv[m][bj][1];
                    u32x4 w; w.x = cvt_pk_bf16(v0[0], v0[1]); w.y = cvt_pk_bf16(v0[2], v0[3]); w.z = cvt_pk_bf16(v1[0], v1[1]); w.w = cvt_pk_bf16(v1[2], v1[3]);
                    *(u32x4*)(x2b + o) = w;
                    ss += (v0[0] * v0[0] + v0[1] * v0[1]) + (v0[2] * v0[2] + v0[3] * v0[3]) + (v1[0] * v1[0] + v1[1] * v1[1]) + (v1[2] * v1[2] + v1[3] * v1[3]);
                }
                ss += xshfl<16>(ss); ss += xshfl<32>(ss);
                if (fq == 0) ssq2[row * 64 + u.pn * 4 + wc] = ss;
            }
        }
    }
};
struct EpiPq {
    static constexpr bool PERM = true, AFTER_DRAIN = false, MIDK = false;
    bf16_t* pq;
    __device__ __forceinline__ void operator()(const f32x4 (&acc)[2][2][4][2], const Unit& u, int wr, int wc, int fr, int fq) const {
        const int row0 = u.pm * BM + wr * 64 + fr, col0 = u.pn * BM + wc * 32 + 8 * fq;
#pragma unroll
        for (int ai = 0; ai < 2; ++ai)
#pragma unroll
            for (int m = 0; m < 4; ++m) {
                bf16_t* rowp = pq + (size_t)(row0 + ai * HALF + m * 16) * PQN + col0;
#pragma unroll
                for (int bj = 0; bj < 2; ++bj) {
                    const f32x4 v0 = acc[ai][bj][m][0], v1 = acc[ai][bj][m][1];
                    u32x4 w; w.x = cvt_pk_bf16(v0[0], v0[1]); w.y = cvt_pk_bf16(v0[2], v0[3]); w.z = cvt_pk_bf16(v1[0], v1[1]); w.w = cvt_pk_bf16(v1[2], v1[3]);
                    *(u32x4*)(rowp + bj * HALF) = w;
                }
            }
    }
};
typedef int i32x4g __attribute__((ext_vector_type(4)));
typedef int i32x8g __attribute__((ext_vector_type(8)));
__device__ __forceinline__ i32x8g cat8(bf16x8 a, bf16x8 b) { return __builtin_shufflevector(__builtin_bit_cast(i32x4g, a), __builtin_bit_cast(i32x4g, b), 0, 1, 2, 3, 4, 5, 6, 7); }
template <class Epi, class Sched, bool STAMP = false, bool F8 = false>
__device__ __forceinline__ void gemm_phase(PG8_LAS unsigned char* lds, const Gemm g, const Sched& S, const Epi& E, unsigned long long* stamps) {
    const int tid = threadIdx.x, wid = __builtin_amdgcn_readfirstlane(tid >> 6), lane = tid & 63, wr = wid >> 2, wc = wid & 3, fr = lane & 15, fq = lane >> 4;
    const int K = g.K, nt = K / BK;
    int ts_lo = 0, ts_hi = 0, nts = 0; const unsigned long long rt_entry = STAMP ? (unsigned long long)wall_clock64() : 0ull;
#define PG8_STAMP() do { if (STAMP && wid == 0 && nts < 64) { const unsigned long long _c = (unsigned long long)clock64(); \
        ts_lo = (lane == nts) ? (int)(unsigned)_c : ts_lo; ts_hi = (lane == nts) ? (int)(unsigned)(_c >> 32) : ts_hi; ++nts; } } while (0)
    PG8_STAMP();
    unsigned voffA[2], voffB[2];
#pragma unroll
    for (int i = 0; i < 2; ++i) { int R, C; stage_rc(tid * 16 + i * 8192, R, C); const int Rb = Epi::PERM ? ((R & ~31) + perm32(R & 31)) : R;
        voffA[i] = (unsigned)(R * K + C) * 2u; voffB[i] = (unsigned)(Rb * K + C) * 2u; }
    const size_t kstep = (size_t)(BK * 2);
    const size_t hstep = (size_t)HALF * K * 2;
    const size_t tstep = 2 * hstep;
    const unsigned ldsw = (unsigned)wid * 1024u;
    const int aoff = lds_byte(wr * 64 + fr, fq * 8), boff = lds_byte(wc * 32 + fr, fq * 8);
#define PG8_SA(b, h) (((b) * 2 + (h)) * HTB)
#define PG8_SB(b, h) ((4 + (b) * 2 + (h)) * HTB)
#define PG8_STAGE(bufoff, gbase, voff) do { _Pragma("unroll") for (int _i = 0; _i < 2; ++_i) { unsigned _vo = (voff)[_i]; asm volatile("" : "+v"(_vo));   \
        __builtin_amdgcn_global_load_lds((const unsigned*)((const char*)(gbase) + _vo), (PG8_LAS unsigned*)(lds + (bufoff) + ldsw + _i * 8192), 16, 0, 0); } } while (0)
#define PG8_LDA(dst, b, h) do { _Pragma("unroll") for (int m = 0; m < 4; ++m) _Pragma("unroll") for (int k = 0; k < 2; ++k) dst[m][k] = *(const PG8_LAS bf16x8*)(lds + PG8_SA(b, h) + aoff + m * 2048 + k * 1024); } while (0)
#define PG8_LDB(dst, b, h) do { _Pragma("unroll") for (int n = 0; n < 2; ++n) _Pragma("unroll") for (int k = 0; k < 2; ++k) dst[n][k] = *(const PG8_LAS bf16x8*)(lds + PG8_SB(b, h) + boff + n * 2048 + k * 1024); } while (0)
#define PG8_MMA(ai, bj, At, Bt) do { __builtin_amdgcn_s_setprio(1); _Pragma("unroll") for (int m = 0; m < 4; ++m) _Pragma("unroll") for (int n = 0; n < 2; ++n) { \
        if constexpr (F8) asm volatile("v_mfma_f32_16x16x128_f8f6f4 %0, %1, %2, %0" : "+v"(acc[ai][bj][m][n]) : "v"(cat8(Bt[n][0], Bt[n][1])), "v"(cat8(At[m][0], At[m][1])));   \
        else { _Pragma("unroll") for (int k = 0; k < 2; ++k) acc[ai][bj][m][n] = __builtin_amdgcn_mfma_f32_16x16x32_bf16(Bt[n][k], At[m][k], acc[ai][bj][m][n], 0, 0, 0); } } \
        __builtin_amdgcn_s_setprio(0); } while (0)
#define PG8_HAZ() asm volatile("s_nop 15\n\ts_nop 15" : "+v"(acc[1][1][0][0]), "+v"(acc[1][1][0][1]), "+v"(acc[1][1][1][0]), "+v"(acc[1][1][1][1]), "+v"(acc[1][1][2][0]), "+v"(acc[1][1][2][1]), "+v"(acc[1][1][3][0]), "+v"(acc[1][1][3][1]))
#define PG8_WAIT_V(n) asm volatile("s_waitcnt vmcnt(" #n ")" ::: "memory")
#define PG8_WAIT_L(n) asm volatile("s_waitcnt lgkmcnt(" #n ")" ::: "memory")
#define PG8_BAR __builtin_amdgcn_s_barrier()
#define PG8_SCHED __builtin_amdgcn_sched_barrier(0)
    Unit cur, nxt; int ui = 0;
    if (!S.next(0, cur)) return;
    f32x4 acc[2][2][4][2];
#pragma unroll
    for (int a = 0; a < 2; ++a)
#pragma unroll
        for (int b = 0; b < 2; ++b)
#pragma unroll
            for (int m = 0; m < 4; ++m)
#pragma unroll
                for (int n = 0; n < 2; ++n) acc[a][b][m][n] = (f32x4){0.f, 0.f, 0.f, 0.f};
    bf16x8 At[4][2], B0[2][2], B1[2][2];
    const char* cA = (const char*)g.A + (size_t)cur.pm * tstep; const char* cB = (const char*)g.Bt + (size_t)cur.pn * tstep;
    S.a_ready(cur);
    PG8_STAGE(PG8_SB(0, 0), cB, voffB); PG8_STAGE(PG8_SA(0, 0), cA, voffA); PG8_STAGE(PG8_SB(0, 1), cB + hstep, voffB); PG8_STAGE(PG8_SA(0, 1), cA + hstep, voffA);
    if (wr == 1) PG8_BAR;
    PG8_WAIT_V(4); PG8_BAR;
    PG8_STAGE(PG8_SB(1, 0), cB + kstep, voffB); PG8_STAGE(PG8_SA(1, 0), cA + kstep, voffA); PG8_STAGE(PG8_SB(1, 1), cB + hstep + kstep, voffB);
    PG8_WAIT_V(6); PG8_BAR;
    PG8_STAMP();
    for (;;) {
        const bool has_next = S.next(ui + 1, nxt);
        const char* nA = has_next ? (const char*)g.A + (size_t)nxt.pm * tstep : cA; const char* nB = has_next ? (const char*)g.Bt + (size_t)nxt.pn * tstep : cB;
        for (int t = 0; t < nt; t += 2) {
            if constexpr (Epi::MIDK) { if (t == nt / 2) { if constexpr (F8) PG8_HAZ(); int l2 = lane; asm volatile("" : "+v"(l2)); E.midk(acc, cur, wr, wc, l2 & 15, l2 >> 4); } }
            const bool last = (t == nt - 2);
            const char* a1 = cA + (size_t)(t + 1) * kstep;
            const char* a2 = last ? nA : cA + (size_t)(t + 2) * kstep; const char* b2 = last ? nB : cB + (size_t)(t + 2) * kstep;
            const char* a3 = a2 + kstep; const char* b3 = b2 + kstep;
            if (last && has_next) S.a_ready(nxt);
            PG8_LDB(B0, 0, 0); PG8_SCHED; PG8_LDA(At, 0, 0); PG8_STAGE(PG8_SA(1, 1), a1 + hstep, voffA);
            PG8_WAIT_L(8); PG8_BAR; PG8_WAIT_L(0); PG8_MMA(0, 0, At, B0); PG8_BAR; PG8_SCHED;
            PG8_LDB(B1, 0, 1); PG8_STAGE(PG8_SB(0, 0), b2, voffB);
            PG8_BAR; PG8_WAIT_L(0); PG8_MMA(0, 1, At, B1); PG8_BAR;
            PG8_LDA(At, 0, 1); PG8_STAGE(PG8_SA(0, 0), a2, voffA);
            PG8_BAR; PG8_WAIT_L(0); PG8_MMA(1, 0, At, B0); PG8_BAR; PG8_SCHED;
            PG8_STAGE(PG8_SB(0, 1), b2 + hstep, voffB);
            PG8_WAIT_V(6); PG8_BAR; PG8_MMA(1, 1, At, B1); PG8_BAR;
            PG8_LDB(B0, 1, 0); PG8_SCHED; PG8_LDA(At, 1, 0); PG8_STAGE(PG8_SA(0, 1), a2 + hstep, voffA);
            PG8_WAIT_L(8); PG8_BAR; PG8_WAIT_L(0); PG8_MMA(0, 0, At, B0); PG8_BAR; PG8_SCHED;
            PG8_LDB(B1, 1, 1); PG8_STAGE(PG8_SB(1, 0), b3, voffB);
            PG8_BAR; PG8_WAIT_L(0); PG8_MMA(0, 1, At, B1); PG8_BAR;
            PG8_LDA(At, 1, 1); PG8_STAGE(PG8_SA(1, 0), a3, voffA);
            PG8_BAR; PG8_WAIT_L(0); PG8_MMA(1, 0, At, B0); PG8_BAR; PG8_SCHED;
            PG8_STAGE(PG8_SB(1, 1), b3 + hstep, voffB);
            PG8_WAIT_V(6); PG8_BAR; PG8_MMA(1, 1, At, B1); PG8_BAR;
        }
        PG8_STAMP();
        if constexpr (F8) PG8_HAZ();
        if constexpr (!Epi::AFTER_DRAIN) { int l2 = lane; asm volatile("" : "+v"(l2));
            E(acc, cur, wr, wc, l2 & 15, l2 >> 4); S.done(cur); }
        PG8_STAMP();
        if (!has_next) break;
#pragma unroll
        for (int a = 0; a < 2; ++a)
#pragma unroll
            for (int b = 0; b < 2; ++b)
#pragma unroll
                for (int m = 0; m < 4; ++m)
#pragma unroll
                    for (int n = 0; n < 2; ++n) acc[a][b][m][n] = (f32x4){0.f, 0.f, 0.f, 0.f};
        cur = nxt; cA = nA; cB = nB; ++ui;
    }
    PG8_WAIT_V(0);
    if (wr == 0) PG8_BAR;
    PG8_BAR;
    if constexpr (Epi::AFTER_DRAIN) { E.fused(acc, cur, wr, wc, fr, fq, lds, wid, lane); S.done(cur); }
    PG8_STAMP();
    if (STAMP && wid == 0) { stamps[lane] = lane < nts ? (((unsigned long long)(unsigned)ts_hi << 32) | (unsigned)ts_lo) : 0ull;
        if (lane == 62) stamps[62] = rt_entry; if (lane == 63) stamps[63] = (unsigned long long)wall_clock64(); }
#undef PG8_STAMP
#undef PG8_SA
#undef PG8_SB
#undef PG8_STAGE
#undef PG8_LDA
#undef PG8_LDB
#undef PG8_MMA
#undef PG8_HAZ
#undef PG8_WAIT_V
#undef PG8_WAIT_L
#undef PG8_BAR
#undef PG8_SCHED
}
}

namespace att {
constexpr int LDK = 2048;
constexpr float SCALE = 0.088388347648318440f;
constexpr float THR2 = 8.f * LOG2E;
constexpr int SHM_V = 64 * 128 * 2, SHM_K = SHM_V;
constexpr int OFF_WS = 2 * SHM_V + 2 * SHM_K, OFF_TBL = OFF_WS + NWAVES * 64 * 4, OFF_Q = OFF_TBL + 704 * 4, ATT_LDS = OFF_Q + NWAVES * 8192;
static_assert(OFF_Q % 16 == 0 && ATT_LDS <= LDS_MISC, "attention LDS map");
#define KSWZ(row, colB) ((row) * 256 + ((colB) ^ (((row) & 7) << 4)))
#define SBAR() __builtin_amdgcn_sched_barrier(0)
__device__ __forceinline__ constexpr int crow(int r, int hi) { return (r & 3) + 8 * (r >> 2) + 4 * hi; }
__device__ __forceinline__ constexpr int kc(int r) { return (r & 3) + 8 * (r >> 2); }

__device__ __forceinline__ void partialSM(f32x16& p0, f32x16& p1, float& m_reg, float& alpha, const float* tp) {
    constexpr float C = SCALE * LOG2E;
#pragma unroll
    for (int r = 0; r < 16; ++r) { p0[r] = fmaf(p0[r], C, tp[59 - kc(r)]); p1[r] = fmaf(p1[r], C, tp[27 - kc(r)]); }
    float pmax = p0[0];
#pragma unroll
    for (int r = 1; r < 16; ++r) pmax = fmaxf(pmax, p0[r]);
#pragma unroll
    for (int r = 0; r < 16; ++r) pmax = fmaxf(pmax, p1[r]);
    { auto rr = __builtin_amdgcn_permlane32_swap(__float_as_uint(pmax), __float_as_uint(pmax), false, false);
      pmax = fmaxf(__uint_as_float(rr[0]), __uint_as_float(rr[1])); }
    float mn;
    if (__builtin_expect(__all(pmax - m_reg <= THR2), 1)) { mn = m_reg; alpha = 1.f; }
    else { mn = fmaxf(m_reg, pmax); alpha = __builtin_amdgcn_exp2f(m_reg - mn); m_reg = mn; }
#pragma unroll
    for (int r = 0; r < 16; ++r) { p0[r] = __builtin_amdgcn_exp2f(p0[r] - mn); p1[r] = p1[r] - mn; }
}
__device__ __forceinline__ void finishSM(f32x16& p0, f32x16& p1, float alpha, float& l_reg, bf16x8& pa0, bf16x8& pa1, bf16x8& pa2, bf16x8& pa3) {
#pragma unroll
    for (int r = 0; r < 16; ++r) p1[r] = __builtin_amdgcn_exp2f(p1[r]);
    float ps = 0;
#pragma unroll
    for (int r = 0; r < 16; ++r) ps += p0[r];
#pragma unroll
    for (int r = 0; r < 16; ++r) ps += p1[r];
    { auto rr = __builtin_amdgcn_permlane32_swap(__float_as_uint(ps), __float_as_uint(ps), false, false);
      ps = __uint_as_float(rr[0]) + __uint_as_float(rr[1]); }
    l_reg = l_reg * alpha + ps;
#define PK4(P, BASE, OUT) do { unsigned a0 = cvtpk(P[BASE + 0], P[BASE + 1]), a1 = cvtpk(P[BASE + 2], P[BASE + 3]);   \
    unsigned b0 = cvtpk(P[BASE + 4], P[BASE + 5]), b1 = cvtpk(P[BASE + 6], P[BASE + 7]);                              \
    auto r0 = __builtin_amdgcn_permlane32_swap(a0, b0, false, false); auto r1 = __builtin_amdgcn_permlane32_swap(a1, b1, false, false); \
    u32x4 w = {r0[0], r1[0], r0[1], r1[1]}; OUT = *reinterpret_cast<bf16x8*>(&w); } while (0)
    PK4(p0, 0, pa0); PK4(p0, 8, pa1); PK4(p1, 0, pa2); PK4(p1, 8, pa3);
#undef PK4
}
__device__ __forceinline__ void qkt(f32x16& p0, f32x16& p1, const char* Ks, const char* qs, int r32, int hi) {
    p0 = f32x16{}; p1 = f32x16{};
#pragma unroll
    for (int d0 = 0; d0 < 8; ++d0) { const int cb = (d0 * 16 + hi * 8) * 2;
        const bf16x8 b0 = *reinterpret_cast<const bf16x8*>(Ks + KSWZ(r32, cb));
        const bf16x8 b1 = *reinterpret_cast<const bf16x8*>(Ks + KSWZ(32 + r32, cb));
        const bf16x8 q = *reinterpret_cast<const bf16x8*>(qs + d0 * 1024);
        p0 = __builtin_amdgcn_mfma_f32_32x32x16_bf16(b0, q, p0, 0, 0, 0);
        p1 = __builtin_amdgcn_mfma_f32_32x32x16_bf16(b1, q, p1, 0, 0, 0); }
}
__device__ __forceinline__ int v_st(int k, int c) { const int kk = (k & ~0xC) | ((k & 4) << 1) | ((k & 8) >> 1); return ((kk >> 3) * 4 + (c >> 5)) * 512 + ((kk & 7) * 32 + (c & 31)) * 2; }
__device__ __forceinline__ int v_rd_base(int lane) { return ((lane & 3) << 3) | (((lane >> 2) & 3) << 6) | (((lane >> 4) & 1) << 5) | (((lane >> 5) & 1) << 8); }
constexpr int v_rd_off(int d0, int ks, int half) { return d0 * 512 + ks * 4096 + half * 2048; }
template <int OFF> __device__ __forceinline__ s16x4 tr_read(int vb) {
    s16x4 r; asm volatile("ds_read_b64_tr_b16 %0, %1 offset:%2" : "=&v"(r) : "v"(vb), "i"(OFF) : "memory"); return r;
}
template <int D0> __device__ __forceinline__ void pv_one(f32x16& od, int vb, bf16x8 pa0, bf16x8 pa1, bf16x8 pa2, bf16x8 pa3) {
    const s16x4 l0 = tr_read<v_rd_off(D0, 0, 0)>(vb), h0 = tr_read<v_rd_off(D0, 0, 1)>(vb), l1 = tr_read<v_rd_off(D0, 1, 0)>(vb), h1 = tr_read<v_rd_off(D0, 1, 1)>(vb);
    const s16x4 l2 = tr_read<v_rd_off(D0, 2, 0)>(vb), h2 = tr_read<v_rd_off(D0, 2, 1)>(vb), l3 = tr_read<v_rd_off(D0, 3, 0)>(vb), h3 = tr_read<v_rd_off(D0, 3, 1)>(vb);
    asm volatile("s_waitcnt lgkmcnt(0)" ::: "memory"); SBAR();
#define PKV(L, H) (bf16x8){L[0], L[1], L[2], L[3], H[0], H[1], H[2], H[3]}
    od = __builtin_amdgcn_mfma_f32_32x32x16_bf16(pa0, PKV(l0, h0), od, 0, 0, 0);
    od = __builtin_amdgcn_mfma_f32_32x32x16_bf16(pa1, PKV(l1, h1), od, 0, 0, 0);
    od = __builtin_amdgcn_mfma_f32_32x32x16_bf16(pa2, PKV(l2, h2), od, 0, 0, 0);
    od = __builtin_amdgcn_mfma_f32_32x32x16_bf16(pa3, PKV(l3, h3), od, 0, 0, 0);
#undef PKV
}
__device__ __forceinline__ void pv_d0(f32x16* o, int vb, bf16x8 pa0, bf16x8 pa1, bf16x8 pa2, bf16x8 pa3) {
    pv_one<0>(o[0], vb, pa0, pa1, pa2, pa3); pv_one<1>(o[1], vb, pa0, pa1, pa2, pa3); pv_one<2>(o[2], vb, pa0, pa1, pa2, pa3); pv_one<3>(o[3], vb, pa0, pa1, pa2, pa3);
}

__device__ __forceinline__ void attn_unit(const bf16_t* __restrict__ Q, const bf16_t* __restrict__ K, const bf16_t* __restrict__ V, const float* __restrict__ relb,
                                          bf16_t* __restrict__ mix, float* __restrict__ assq, int b, int h, int g, char* lds) {
    const int tid = threadIdx.x, wid = tid >> 6, lane = tid & 63, r32 = lane & 31, hi = lane >> 5;
    const int c0 = 4 * g, jp = wid >> 1;
    const size_t tokb = (size_t)b * SEQ;
    char* V_lds = lds; char* K_lds = lds + 2 * SHM_V;
    float* ws = (float*)(lds + OFF_WS) + wid * 64; float* li_l = ws; float* al_l = ws + 32;
    float* tbl = (float*)(lds + OFF_TBL);
    __syncthreads();
    for (int i = tid; i < 704; i += NTHREADS) { const int diff = i - 63; const int idx = (diff > 256 ? 256 : diff) + 256; tbl[i] = (i < 639) ? relb[h * NREL + idx] * LOG2E : -__builtin_inff(); }
    float m_reg = -1e30f, l_reg = 0.f; f32x16 o[4] = {};
    char* qr = lds + OFF_Q + wid * 8192 + lane * 16;
    const size_t qtok = tokb + (size_t)c0 * 64 + wid * 32;
    const bf16_t* Qw = Q + (qtok + r32) * LDK + h * HD + hi * 8;
#pragma unroll
    for (int d0 = 0; d0 < 8; ++d0) *reinterpret_cast<bf16x8*>(qr + d0 * 1024) = *reinterpret_cast<const bf16x8*>(Qw + d0 * 16);
    const int sr = tid >> 4, sc = (tid & 15) * 8, vst0 = v_st(sr, sc), vst1 = v_st(32 + sr, sc);
    const int vb0 = (int)(uintptr_t)V_lds + v_rd_base(lane);
    const bf16_t* Kh = K + tokb * LDK + h * HD + (size_t)sr * LDK + sc; const bf16_t* Vh = V + tokb * LDK + h * HD + (size_t)sr * LDK + sc;
    bf16x8 vs0, vs1, ks0, ks1;
#define KT(t) ((c0 - 8 + (t)) < 0 ? 0 : (c0 - 8 + (t)))
#define SLOAD(t) do { const size_t k0_ = (size_t)KT(t) * 64 * LDK; vs0 = *reinterpret_cast<const bf16x8*>(Vh + k0_); vs1 = *reinterpret_cast<const bf16x8*>(Vh + k0_ + 32 * LDK); \
    ks0 = *reinterpret_cast<const bf16x8*>(Kh + k0_); ks1 = *reinterpret_cast<const bf16x8*>(Kh + k0_ + 32 * LDK); } while (0)
#define SWRITE(t) do { const int bo_ = ((t) & 1) * SHM_V; *(bf16x8*)(V_lds + bo_ + vst0) = vs0; *(bf16x8*)(V_lds + bo_ + vst1) = vs1; const int kcB = sc * 2; \
    *(bf16x8*)(K_lds + bo_ + KSWZ(sr, kcB)) = ks0; *(bf16x8*)(K_lds + bo_ + KSWZ(32 + sr, kcB)) = ks1; } while (0)
#define RESC(a) do { if (__any((a) < 1.f)) { if (hi == 0) al_l[r32] = (a); asm volatile("s_waitcnt lgkmcnt(0)" ::: "memory"); \
    _Pragma("unroll") for (int d = 0; d < 4; ++d) _Pragma("unroll") for (int r = 0; r < 16; ++r) o[d][r] *= al_l[crow(r, hi)]; } } while (0)
#define TP(t) (((c0 - 8 + (t)) < 0) ? (tbl + 640) : (tbl + ((jp + 8 - (t)) * 64 + (wid & 1) * 32 + r32 + 4 - 4 * hi)))
#define KB(t) (K_lds + ((t) & 1) * SHM_K)
#define VB(t) (vb0 + ((t) & 1) * SHM_V)
#define ST_HEAD(t) do { if ((t) + 1 <= 11) SLOAD((t) + 1); } while (0)
#define ST_TAIL(t, resc) do { __syncthreads(); if ((t) + 1 <= 11) SWRITE((t) + 1); resc; __syncthreads(); } while (0)
    f32x16 pA0, pA1, pB0, pB1; float alA = 1.f, alB = 1.f; bf16x8 pa0, pa1, pa2, pa3;
    SLOAD(0); asm volatile("s_waitcnt vmcnt(0)" ::: "memory"); SWRITE(0); __syncthreads();
    int t = 0;
    for (; t < jp; ++t) { ST_HEAD(t); ST_TAIL(t, (void)0); }
    {
        SBAR(); qkt(pA0, pA1, KB(t), qr, r32, hi); ST_HEAD(t); SBAR();
        partialSM(pA0, pA1, m_reg, alA, TP(t));
        ST_TAIL(t, RESC(alA)); ++t;
    }
#pragma unroll 1
    for (int it = 0; it < 4; ++it) {
        {
            SBAR(); qkt(pB0, pB1, KB(t), qr, r32, hi);
            finishSM(pA0, pA1, alA, l_reg, pa0, pa1, pa2, pa3); SBAR();
            ST_HEAD(t); SBAR();
            pv_d0(o, VB(t - 1), pa0, pa1, pa2, pa3); partialSM(pB0, pB1, m_reg, alB, TP(t));
            ST_TAIL(t, RESC(alB)); ++t;
        }
        {
            SBAR(); qkt(pA0, pA1, KB(t), qr, r32, hi);
            finishSM(pB0, pB1, alB, l_reg, pa0, pa1, pa2, pa3); SBAR();
            ST_HEAD(t); SBAR();
            pv_d0(o, VB(t - 1), pa0, pa1, pa2, pa3); partialSM(pA0, pA1, m_reg, alA, TP(t));
            ST_TAIL(t, RESC(alA)); ++t;
        }
    }
    {
        finishSM(pA0, pA1, alA, l_reg, pa0, pa1, pa2, pa3); SBAR();
        if (t <= 11) ST_HEAD(t);
        SBAR(); pv_d0(o, VB(t - 1), pa0, pa1, pa2, pa3);
        if (t <= 11) { ST_TAIL(t, (void)0); }
        ++t;
    }
    for (; t <= 11; ++t) { ST_HEAD(t); ST_TAIL(t, (void)0); }
    if (hi == 0) li_l[r32] = l_reg;
    asm volatile("s_waitcnt lgkmcnt(0)" ::: "memory");
    int tid2 = tid; asm volatile("" : "+v"(tid2));
    const int lane2 = tid2 & 63, hi2 = lane2 >> 5, r32b = lane2 & 31, wid2 = tid2 >> 6;
    bf16_t* stg = (bf16_t*)(lds + OFF_Q + wid2 * 8192);
#pragma unroll
    for (int r = 0; r < 16; ++r) {
        const int orow = crow(r, hi2);
        const float rl = __builtin_amdgcn_rcpf(li_l[orow]);
#pragma unroll
        for (int d0 = 0; d0 < 4; ++d0) stg[orow * 128 + d0 * 32 + r32b] = (bf16_t)(cvtpk(o[d0][r] * rl, 0.f) & 0xffffu);
    }
    asm volatile("s_waitcnt lgkmcnt(0)" ::: "memory");
    {
        const int rsub = lane2 >> 4, c16 = lane2 & 15;
#pragma unroll
        for (int i = 0; i < 8; ++i) {
            const int row = 4 * i + rsub;
            const u32x4 w = *reinterpret_cast<const u32x4*>(stg + row * 128 + c16 * 8);
            float s = (bf_lo(w.x) * bf_lo(w.x) + bf_hi(w.x) * bf_hi(w.x)) + (bf_lo(w.y) * bf_lo(w.y) + bf_hi(w.y) * bf_hi(w.y)) + (bf_lo(w.z) * bf_lo(w.z) + bf_hi(w.z) * bf_hi(w.z)) + (bf_lo(w.w) * bf_lo(w.w) + bf_hi(w.w) * bf_hi(w.w));
            s += xshfl<1>(s); s += xshfl<2>(s); s += xshfl<4>(s); s += xshfl<8>(s);
            uint2 w8; w8.x = cvt4_fp8(bf_lo(w.x) * MIX_SA, bf_hi(w.x) * MIX_SA, bf_lo(w.y) * MIX_SA, bf_hi(w.y) * MIX_SA); w8.y = cvt4_fp8(bf_lo(w.z) * MIX_SA, bf_hi(w.z) * MIX_SA, bf_lo(w.w) * MIX_SA, bf_hi(w.w) * MIX_SA);
            *reinterpret_cast<uint2*>((unsigned char*)mix + (qtok + row) * DM + h * HD + c16 * 8) = w8;
            if (c16 == 0) assq[(qtok + row) * 16 + h] = s;
        }
    }
#undef KT
#undef SLOAD
#undef SWRITE
#undef RESC
#undef TP
#undef KB
#undef VB
#undef ST_HEAD
#undef ST_TAIL
}
}

namespace rec {
constexpr int XIN_OFF = 0, XIN_BYTES = 67 * 128 * 2;
constexpr int XRA_OFF = 17408, XRA_LD = 136;
constexpr int AL_OFF = 36864, UL_OFF = AL_OFF + 64 * 128 * 4, REC_LDS = UL_OFF + 64 * 128 * 4;
static_assert(XIN_BYTES <= XRA_OFF && XRA_OFF + 64 * XRA_LD * 2 <= AL_OFF, "rec LDS map");

__device__ __forceinline__ void rec_chain(const bf16_t* __restrict__ xrec, const bf16_t* __restrict__ gy, const float* __restrict__ conv_w, const float* __restrict__ conv_b,
                                          const bf16_t* __restrict__ wgt, const float* __restrict__ b_a, const float* __restrict__ b_x, const float* __restrict__ lam,
                                          bf16_t* __restrict__ mix, float* __restrict__ rssq, int b, int n, char* lds) {
    const int tid = threadIdx.x, wid = tid >> 6, lane = tid & 63, r32 = lane & 31, hi = lane >> 5, wr = wid >> 2, wc = wid & 3;
    bf16_t* xin = (bf16_t*)(lds + XIN_OFF); bf16_t* xra = (bf16_t*)(lds + XRA_OFF); float* aL = (float*)(lds + AL_OFF); float* uL = (float*)(lds + UL_OFF);
    const size_t tokb = (size_t)b * SEQ;
    const int cc = tid & 127, tq = tid >> 7, chg = n * RBD + cc;
    const float w0 = conv_w[0 * DREC + chg], w1 = conv_w[1 * DREC + chg], w2 = conv_w[2 * DREC + chg], w3 = conv_w[3 * DREC + chg], cb = conv_b[chg];
    const int cg = 32 * wc + r32, cgg = n * RBD + cg;
    const float ba = b_a[cgg], bx = b_x[cgg];
    const float sp8 = -8.0f * log1pf(expf(-lam[cgg])) * LOG2E;
    bf16x8 wa[8], wx[8];
#pragma unroll
    for (int s = 0; s < 8; ++s) {
        wa[s] = *reinterpret_cast<const bf16x8*>(wgt + ((size_t)(n * 2 + 0) * 128 + cg) * 128 + 16 * s + 8 * hi);
        wx[s] = *reinterpret_cast<const bf16x8*>(wgt + ((size_t)(n * 2 + 1) * 128 + cg) * 128 + 16 * s + 8 * hi);
    }
    __syncthreads();
    if (tid < 384) xin[tid] = 0;
    float hcar = 0.f;
    const int lrow = tid >> 3, lcol = (tid & 7) * 16;
    const bf16_t* xsrc = xrec + (tokb + lrow) * 2048 + n * RBD + lcol; const bf16_t* gsrc = gy + (tokb + lrow) * 2048 + n * RBD + lcol;
    u32x4 xn0 = *reinterpret_cast<const u32x4*>(xsrc), xn1 = *reinterpret_cast<const u32x4*>(xsrc + 8);
    u32x4 gn0 = *reinterpret_cast<const u32x4*>(gsrc), gn1 = *reinterpret_cast<const u32x4*>(gsrc + 8);
    for (int tile = 0; tile < SEQ / 64; ++tile) {
        const size_t t0 = tokb + (size_t)tile * 64;
        const u32x4 g0 = gn0, g1 = gn1;
        {
            *reinterpret_cast<u32x4*>(xin + (3 + lrow) * 128 + lcol) = xn0; *reinterpret_cast<u32x4*>(xin + (3 + lrow) * 128 + lcol + 8) = xn1;
            if (tile + 1 < SEQ / 64) {
                const size_t o = (size_t)(tile + 1) * 64 * 2048;
                xn0 = *reinterpret_cast<const u32x4*>(xsrc + o); xn1 = *reinterpret_cast<const u32x4*>(xsrc + o + 8);
                gn0 = *reinterpret_cast<const u32x4*>(gsrc + o); gn1 = *reinterpret_cast<const u32x4*>(gsrc + o + 8);
            }
        }
        __syncthreads();
        {
            float x0 = bf2f(xin[(16 * tq + 0) * 128 + cc]), x1 = bf2f(xin[(16 * tq + 1) * 128 + cc]), x2 = bf2f(xin[(16 * tq + 2) * 128 + cc]);
#pragma unroll
            for (int tt = 0; tt < 16; ++tt) {
                const float x3 = bf2f(xin[(16 * tq + tt + 3) * 128 + cc]);
                const float v = cb + w0 * x0 + w1 * x1 + w2 * x2 + w3 * x3;
                xra[(16 * tq + tt) * XRA_LD + cc] = (bf16_t)(cvtpk(v, 0.f) & 0xffffu);
                x0 = x1; x1 = x2; x2 = x3;
            }
        }
        __syncthreads();
        if (tid < 384) xin[tid] = xin[64 * 128 + tid];
        {
            f32x16 ga = {}, gx = {};
#pragma unroll
            for (int s = 0; s < 8; ++s) {
                const bf16x8 af = *reinterpret_cast<const bf16x8*>(xra + (32 * wr + r32) * XRA_LD + 16 * s + 8 * hi);
                ga = __builtin_amdgcn_mfma_f32_32x32x16_bf16(af, wa[s], ga, 0, 0, 0);
                gx = __builtin_amdgcn_mfma_f32_32x32x16_bf16(af, wx[s], gx, 0, 0, 0);
            }
#pragma unroll
            for (int r = 0; r < 16; ++r) {
                const int t = 32 * wr + att::crow(r, hi);
                const float xv = bf2f(xra[t * XRA_LD + cg]);
                const float rg = sigmoid_f(ga[r] + ba), ig = sigmoid_f(gx[r] + bx);
                const float l2a = sp8 * rg;
                const float av = __builtin_amdgcn_exp2f(l2a);
                const float xx = 2.0f * 0.6931471805599453f * l2a;
                const float poly = -xx * (1.0f + xx * (0.5f + xx * (0.16666667f + xx * (0.041666668f + xx * (0.008333334f + xx * 0.0013888889f)))));
                const float om = (xx > -0.3f) ? poly : (1.0f - av * av);
                const float mult = __builtin_amdgcn_sqrtf(om);
                aL[t * 128 + cg] = av; uL[t * 128 + cg] = mult * ig * xv;
            }
        }
        __syncthreads();
        if (tid < 128) {
#pragma unroll 1
            for (int tb = 0; tb < 64; tb += 16) {
                float av[16], uv[16];
#pragma unroll
                for (int i = 0; i < 16; ++i) { av[i] = aL[(tb + i) * 128 + tid]; uv[i] = uL[(tb + i) * 128 + tid]; }
#pragma unroll
                for (int i = 0; i < 16; ++i) { hcar = fmaf(av[i], hcar, uv[i]); uv[i] = hcar; }
#pragma unroll
                for (int i = 0; i < 16; ++i) uL[(tb + i) * 128 + tid] = uv[i];
            }
        }
        __syncthreads();
        {
            const float* hp = uL + lrow * 128 + lcol;
            float ss = 0.f; float a[16];
#pragma unroll
            for (int j = 0; j < 4; ++j) { a[2 * j] = hp[2 * j] * bf_lo(g0[j]); a[2 * j + 1] = hp[2 * j + 1] * bf_hi(g0[j]); a[8 + 2 * j] = hp[8 + 2 * j] * bf_lo(g1[j]); a[8 + 2 * j + 1] = hp[8 + 2 * j + 1] * bf_hi(g1[j]); }
            u32x4 o;
#pragma unroll
            for (int j = 0; j < 4; ++j) { ss += (a[4 * j] * a[4 * j] + a[4 * j + 1] * a[4 * j + 1]) + (a[4 * j + 2] * a[4 * j + 2] + a[4 * j + 3] * a[4 * j + 3]);
                o[j] = cvt4_fp8(a[4 * j] * MIX_SR, a[4 * j + 1] * MIX_SR, a[4 * j + 2] * MIX_SR, a[4 * j + 3] * MIX_SR); }
            unsigned char* dst = (unsigned char*)mix + (t0 + lrow) * DM + DATT + n * RBD + lcol;
            *reinterpret_cast<u32x4*>(dst) = o;
            ss += xshfl<1>(ss); ss += xshfl<2>(ss); ss += xshfl<4>(ss);
            if ((tid & 7) == 0) rssq[(t0 + lrow) * 16 + n] = ss;
        }
        __syncthreads();
    }
}
}

#ifndef TABLES_IN_P2
#define TABLES_IN_P2 1
#endif
struct Args {
    const float* in[22]; float* out; unsigned char* ws; int ph_lo, ph_hi;
};
struct TDesc { const float* src; bf16_t* dst; const float* gain; int K, N, k0, n0, f8; };
constexpr int TT = 128, TLD = 129;
__device__ __forceinline__ TDesc tile_desc(const Args& a, int t) {
    unsigned char* ws = a.ws; unsigned char* sm = ws + WS_SMALL;
    constexpr int n_in = (DM / TT) * (NIN / TT), n_out = (DM / TT) * (DM / TT), n_pq = (DM / TT) * (PQN / TT);
    TDesc d;
    if (t < n_in) { const int kt = t / (NIN / TT), nt = t % (NIN / TT); d = TDesc{a.in[2], (bf16_t*)(ws + WS_WIN), a.in[1], DM, NIN, kt * TT, nt * TT, 0}; }
    else if (t < n_in + n_out) { const int u = t - n_in, kt = u / (DM / TT), nt = u % (DM / TT); d = TDesc{a.in[15], (bf16_t*)(ws + WS_WOUT), kt * TT < DATT ? a.in[13] : a.in[14] - DATT, DM, DM, kt * TT, nt * TT, 1}; }
    else if (t < n_in + n_out + n_pq) { const int u = t - n_in - n_out, kt = u / (PQN / TT), nt = u % (PQN / TT); d = TDesc{a.in[17], (bf16_t*)(ws + WS_WPQ), a.in[16], DM, PQN, kt * TT, nt * TT, 0}; }
    else { const int u = t - n_in - n_out - n_pq, blk = u >> 1, gate = u & 1;
           d = TDesc{a.in[gate ? 10 : 8] + (size_t)blk * 128 * 128, (bf16_t*)(sm + SM_WGT) + (size_t)(blk * 2 + gate) * 128 * 128, nullptr, 128, 128, 0, 0, 0}; }
    return d;
}
__device__ __forceinline__ void tile_load(const TDesc& d, int tid, f32x4 (&v)[8]) {
    const int r = tid >> 5, c4 = (tid & 31) * 4;
    const float* p = d.src + (size_t)(d.k0 + r) * d.N + d.n0 + c4;
#pragma unroll
    for (int j = 0; j < 8; ++j) v[j] = *reinterpret_cast<const f32x4*>(p + (size_t)(16 * j) * d.N);
    if (d.gain) { const float sc = d.f8 ? W8S : 1.0f;
#pragma unroll
        for (int j = 0; j < 8; ++j) v[j] = v[j] * (d.gain[d.k0 + r + 16 * j] * sc); }
}
__device__ __forceinline__ void tile_store(const TDesc& d, int tid, const f32x4 (&v)[8], float* tile) {
    const int r = tid >> 5, c4 = (tid & 31) * 4;
#pragma unroll
    for (int j = 0; j < 8; ++j) { float* tp = tile + (r + 16 * j) * TLD + c4; tp[0] = v[j][0]; tp[1] = v[j][1]; tp[2] = v[j][2]; tp[3] = v[j][3]; }
    __syncthreads();
    const int nn = tid >> 2, kq = (tid & 3) * 32;
    const float* cp = tile + kq * TLD + nn;
    if (d.f8) { u32x4 o[2];
#pragma unroll
        for (int i = 0; i < 8; ++i) o[i >> 2][i & 3] = cvt4_fp8(cp[(4 * i) * TLD], cp[(4 * i + 1) * TLD], cp[(4 * i + 2) * TLD], cp[(4 * i + 3) * TLD]);
        u32x4* dp = reinterpret_cast<u32x4*>((unsigned char*)d.dst + (size_t)(d.n0 + nn) * d.K + d.k0 + kq); dp[0] = o[0]; dp[1] = o[1]; }
    else { u32x4 o[4];
#pragma unroll
        for (int i = 0; i < 16; ++i) o[i >> 2][i & 3] = cvtpk(cp[(2 * i) * TLD], cp[(2 * i + 1) * TLD]);
        u32x4* dp = reinterpret_cast<u32x4*>(d.dst + (size_t)(d.n0 + nn) * d.K + d.k0 + kq); dp[0] = o[0]; dp[1] = o[1]; dp[2] = o[2]; dp[3] = o[3]; }
    __syncthreads();
}
constexpr int NT_IN = (DM / TT) * (NIN / TT), NT_OUT = (DM / TT) * (DM / TT), NT_PQ = (DM / TT) * (PQN / TT), NT_GATE = 16 * 2;
template <bool P0MAP>
__device__ __forceinline__ void transpose_seq(const Args& a, char* lds, int first, int step, int n) {
    int tid = threadIdx.x; asm volatile("" : "+v"(tid));
    float* tile = (float*)lds;
    auto tmap = [](int c) { return P0MAP ? (c < NT_IN ? c : c + NT_OUT + NT_PQ) : NT_IN + c; };
    int t = first;
    if (t < n) {
        TDesc cur = tile_desc(a, tmap(t)); f32x4 c[8]; tile_load(cur, tid, c);
        for (;;) {
            const int tn = t + step; const bool more = tn < n;
            TDesc nxt = cur; f32x4 nn[8];
#pragma unroll
            for (int j = 0; j < 8; ++j) nn[j] = c[j];
            if (more) { nxt = tile_desc(a, tmap(tn)); tile_load(nxt, tid, nn); }
            tile_store(cur, tid, c, tile);
            if (!more) break;
            cur = nxt; t = tn;
#pragma unroll
            for (int j = 0; j < 8; ++j) c[j] = nn[j];
        }
    }
}
constexpr int TR_ITEM_TILES = 8, TR_ITEMS = (NT_OUT + NT_PQ) / TR_ITEM_TILES;
__device__ __forceinline__ void p0_tables_rows(const Args& a, int r0, int rstep, int rend) {
    int tid = threadIdx.x; asm volatile("" : "+v"(tid)); const int lane = tid & 63;
    unsigned char* ws = a.ws; unsigned char* sm = ws + WS_SMALL;
    {
        const float* g2 = a.in[16];
        float* su = (float*)(sm + SM_SU); float* sv = (float*)(sm + SM_SV); float* rsum = (float*)(sm + SM_RSUM);
        int r = r0;
        f32x4 nq[16];
        if (r < rend) { const float* s0 = (r >= NEXP ? a.in[21] + (size_t)(r - NEXP) * DM : a.in[20] + (size_t)r * DM) + lane * 4;
#pragma unroll
            for (int i = 0; i < 16; ++i) nq[i] = *reinterpret_cast<const f32x4*>(s0 + 256 * i); }
        for (; r < rend; r += rstep) {
            const bool isv = r >= NEXP; const int e = isv ? r - NEXP : r;
            f32x4 q[16]; float mx = 0.f, ss = 0.f;
#pragma unroll
            for (int i = 0; i < 16; ++i) q[i] = nq[i];
            { const int rn = r + rstep;
              if (rn < rend) { const float* s1 = (rn >= NEXP ? a.in[21] + (size_t)(rn - NEXP) * DM : a.in[20] + (size_t)rn * DM) + lane * 4;
#pragma unroll
                for (int i = 0; i < 16; ++i) nq[i] = *reinterpret_cast<const f32x4*>(s1 + 256 * i); } }
#pragma unroll
            for (int i = 0; i < 16; ++i) {
                f32x4 x = q[i];
                if (!isv) { const f32x4 gg = *reinterpret_cast<const f32x4*>(g2 + lane * 4 + 256 * i); x = x * gg; }
                q[i] = x;
                mx = fmaxf(mx, fmaxf(fmaxf(fabsf(x[0]), fabsf(x[1])), fmaxf(fabsf(x[2]), fabsf(x[3]))));
                ss += (x[0] * x[0] + x[1] * x[1]) + (x[2] * x[2] + x[3] * x[3]);
            }
            mx = wave_max(mx);
            mx = fmaxf(mx, 1e-30f);
            unsigned wd[8];
            if (isv) {
                const float sc = 6.0f / mx;
                if (lane == 0) sv[e] = mx * (1.0f / 6.0f);
#pragma unroll
                for (int d = 0; d < 8; ++d) {
                    unsigned w = 0;
                    w = __builtin_amdgcn_cvt_scalef32_pk_fp4_f32(w, q[2 * d][0] * sc, q[2 * d][1] * sc, 1.0f, 0);
                    w = __builtin_amdgcn_cvt_scalef32_pk_fp4_f32(w, q[2 * d][2] * sc, q[2 * d][3] * sc, 1.0f, 1);
                    w = __builtin_amdgcn_cvt_scalef32_pk_fp4_f32(w, q[2 * d + 1][0] * sc, q[2 * d + 1][1] * sc, 1.0f, 2);
                    w = __builtin_amdgcn_cvt_scalef32_pk_fp4_f32(w, q[2 * d + 1][2] * sc, q[2 * d + 1][3] * sc, 1.0f, 3);
                    wd[d] = w;
                }
            } else {
                ss = wave_sum(ss);
                const float step = fmaxf(fmaxf(0.335f * sqrtf(ss * (1.0f / DM)), mx * 0.05f), 1e-30f);
                const float inv = 1.0f / step;
                int qs = 0;
#pragma unroll
                for (int d = 0; d < 8; ++d) {
                    unsigned w = 0;
#pragma unroll
                    for (int j = 0; j < 8; ++j) {
                        const float xv = q[2 * d + (j >> 2)][j & 3];
                        const int qi = (int)fminf(fmaxf(rintf(xv * inv), -8.0f), 7.0f);
                        qs += qi;
                        w |= (unsigned)(qi & 15) << (4 * j);
                    }
                    wd[d] = w;
                }
                const float qsf = wave_sum((float)qs);
                if (lane == 0) { su[e] = step; rsum[e] = qsf; }
            }
            unsigned char* dst = ws + (isv ? WS_VB : WS_UB) + (size_t)e * V4ROW + lane * 16;
            *reinterpret_cast<u32x4*>(dst) = (u32x4){wd[0], wd[1], wd[2], wd[3]};
            *reinterpret_cast<u32x4*>(dst + 1024) = (u32x4){wd[4], wd[5], wd[6], wd[7]};
        }
    }
}
__device__ __forceinline__ void p0_tables(const Args& a) {
    p0_tables_rows(a, (int)blockIdx.x * NWAVES + ((int)threadIdx.x >> 6), (int)gridDim.x * NWAVES, 2 * NEXP);
}
constexpr int TBL_ITEMS = 2 * NEXP / 64;
__device__ __forceinline__ void p0_tables_item(const Args& a, int item) {
    const int r0 = item * 64 + ((int)threadIdx.x >> 6) * 8;
    p0_tables_rows(a, r0, 1, r0 + 8);
}
__device__ __forceinline__ void p0_prologue(const Args& a, char* lds) {
    const int tid = threadIdx.x, lane = tid & 63, wid = tid >> 6, G = gridDim.x, bid = blockIdx.x;
    unsigned char* ws = a.ws; unsigned char* sm = ws + WS_SMALL;
    {
        const float* x = a.in[0]; bf16_t* xb = (bf16_t*)(ws + WS_XB); float* rstd1 = (float*)(sm + SM_RSTD1);
        const int rstep = G * NWAVES; int row = bid * NWAVES + wid;
        f32x4 nx[16];
        if (row < TOK) { const f32x4* s0 = reinterpret_cast<const f32x4*>(x + (size_t)row * DM);
#pragma unroll
            for (int i = 0; i < 16; ++i) nx[i] = s0[lane + 64 * i]; }
        for (; row < TOK; row += rstep) {
            uint2* dst = reinterpret_cast<uint2*>(xb + (size_t)row * DM);
            f32x4 cx[16];
#pragma unroll
            for (int i = 0; i < 16; ++i) cx[i] = nx[i];
            if (row + rstep < TOK) { const f32x4* s1 = reinterpret_cast<const f32x4*>(x + (size_t)(row + rstep) * DM);
#pragma unroll
                for (int i = 0; i < 16; ++i) nx[i] = s1[lane + 64 * i]; }
            float ss = 0.f;
#pragma unroll
            for (int i = 0; i < 16; ++i) {
                const f32x4 p = cx[i];
                ss += (p[0] * p[0] + p[1] * p[1]) + (p[2] * p[2] + p[3] * p[3]);
                uint2 o; o.x = cvtpk(p[0], p[1]); o.y = cvtpk(p[2], p[3]);
                dst[lane + 64 * i] = o;
            }
            ss = wave_sum(ss);
            if (lane == 0) rstd1[row] = __builtin_amdgcn_rsqf(ss * (1.0f / DM) + EPS);
        }
    }
#if TABLES_IN_P2
    transpose_seq<true>(a, lds, bid, G, NT_IN + NT_GATE);
#else
    { float* tile = (float*)lds; int tidl = tid;
      constexpr int n_tiles = NT_IN + NT_OUT + NT_PQ + NT_GATE;
      int t = bid;
      if (t < n_tiles) {
          TDesc cur = tile_desc(a, t); f32x4 c[8]; tile_load(cur, tidl, c);
          for (;;) {
              const int tn = t + G; const bool more = tn < n_tiles;
              TDesc nxt = cur; f32x4 n[8];
#pragma unroll
              for (int j = 0; j < 8; ++j) n[j] = c[j];
              if (more) { nxt = tile_desc(a, tn); tile_load(nxt, tidl, n); }
              tile_store(cur, tidl, c, tile);
              if (!more) break;
              cur = nxt; t = tn;
#pragma unroll
              for (int j = 0; j < 8; ++j) c[j] = n[j];
          }
      }
    }
#endif
    {
        const size_t gt = (size_t)bid * NTHREADS + tid, nth = (size_t)G * NTHREADS;
        const size_t nk8 = (size_t)PH * PNK * 128 / 8;
        u32x4* kb = reinterpret_cast<u32x4*>(sm + SM_KEYS);
        for (size_t i = gt; i < 2 * nk8; i += nth) {
            const f32x4* ks = reinterpret_cast<const f32x4*>(i < nk8 ? a.in[18] : a.in[19]); const size_t j = i < nk8 ? i : i - nk8;
            const f32x4 p = ks[2 * j], q = ks[2 * j + 1];
            u32x4 o; o.x = cvtpk(p[0], p[1]); o.y = cvtpk(p[2], p[3]); o.z = cvtpk(q[0], q[1]); o.w = cvtpk(q[2], q[3]);
            kb[i] = o;
        }
    }
}


namespace peer {
constexpr int SKEY = 0, SEL_G = 64 * 128 * 4, ABUFO = 2 * 64 * 128 * 4, SCR = 3 * 64 * 128 * 4, R2 = SCR + NWAVES * 32 * 32 * 4, SXL = R2 + 64 * 4, PEER_LDS = SXL + 64 * 4;
static_assert(PEER_LDS <= LDS_MISC, "peer LDS map");
#ifndef PEER_WBITS
#define PEER_WBITS 11
#endif
constexpr int WSHIFT = 7 + PEER_WBITS;
constexpr int NWIN = NEXP >> PEER_WBITS;
constexpr int UCH = 8, VCH = 8;
constexpr int UG = 4, UR = 8 / UG;
constexpr float NEG = -3.0e38f;

__device__ __forceinline__ void ins16(float (&t)[16], float x) {
#pragma unroll
    for (int i = 0; i < 16; ++i) { const float hi = fmaxf(t[i], x); x = fminf(t[i], x); t[i] = hi; }
}
__device__ __forceinline__ void sort16(float (&t)[16]) {
#define SCE(K, J) _Pragma("unroll") for (int i = 0; i < 16; ++i) { const int l = i ^ (J); if (l > i) { const float hi = fmaxf(t[i], t[l]), lo = fminf(t[i], t[l]); \
        if ((i & (K)) == 0) { t[i] = hi; t[l] = lo; } else { t[i] = lo; t[l] = hi; } } }
    SCE(2, 1) SCE(4, 2) SCE(4, 1) SCE(8, 4) SCE(8, 2) SCE(8, 1) SCE(16, 8) SCE(16, 4) SCE(16, 2) SCE(16, 1)
#undef SCE
}
__device__ __forceinline__ void merge16(float (&t)[16], const float (&b)[16]) {
#pragma unroll
    for (int i = 0; i < 16; ++i) t[i] = fmaxf(t[i], b[15 - i]);
#define MCE(D) _Pragma("unroll") for (int i = 0; i < 16; ++i) if ((i & (D)) == 0) { const float hi = fmaxf(t[i], t[i + (D)]), lo = fminf(t[i], t[i + (D)]); t[i] = hi; t[i + (D)] = lo; }
    MCE(8) MCE(4) MCE(2) MCE(1)
#undef MCE
}
__device__ __forceinline__ void merge_partner(float (&t)[16]) {
    float m[16];
#pragma unroll
    for (int i = 0; i < 16; ++i) { const float p = xshfl<32>(t[15 - i]); m[i] = fmaxf(t[i], p); }
#define CE_STAGE(d) _Pragma("unroll") for (int i = 0; i < 16; ++i) if ((i & (d)) == 0) { const float hi = fmaxf(m[i], m[i + (d)]), lo = fminf(m[i], m[i + (d)]); m[i] = hi; m[i + (d)] = lo; }
    CE_STAGE(8) CE_STAGE(4) CE_STAGE(2) CE_STAGE(1)
#undef CE_STAGE
#pragma unroll
    for (int i = 0; i < 16; ++i) t[i] = m[i];
}
__device__ __forceinline__ void side_topk(const bf16_t* __restrict__ qb, const bf16_t* __restrict__ kb, float rs, int r32, int hi, float (&t)[16]) {
    bf16x8 qf[8];
#pragma unroll
    for (int s = 0; s < 8; ++s) qf[s] = *reinterpret_cast<const bf16x8*>(qb + 16 * s);
#pragma unroll
    for (int nb = 0; nb < 4; ++nb) {
        f32x16 acc = {};
        const bf16_t* kr = kb + (size_t)(32 * nb + r32) * 128 + 8 * hi;
#pragma unroll
        for (int s = 0; s < 8; ++s) { const bf16x8 kf = *reinterpret_cast<const bf16x8*>(kr + 16 * s); acc = __builtin_amdgcn_mfma_f32_32x32x16_bf16(kf, qf[s], acc, 0, 0, 0); }
        float blk[16];
#pragma unroll
        for (int r = 0; r < 16; ++r) {
            const unsigned n = 32 * nb + att::crow(r, hi);
            blk[r] = __uint_as_float((__float_as_uint(acc[r] * rs) & ~127u) | n);
        }
        sort16(blk);
        if (nb == 0) {
#pragma unroll
            for (int i = 0; i < 16; ++i) t[i] = blk[i];
        } else merge16(t, blk);
    }
    merge_partner(t);
}

__device__ __forceinline__ void xcc_rendezvous(const XcdBarrier& b, unsigned* cnt) {
    __syncthreads();
    if (threadIdx.x == 0) {
        const unsigned nloc = b.st[0];
        if (nloc) { unsigned* w = cnt + 64 * b.x; __hip_atomic_fetch_add(w, 1u, RLX_AGENT);
            unsigned sp = 0; while (__hip_atomic_load(w, RLX_AGENT) < nloc && ++sp < (1u << 15)) __builtin_amdgcn_s_sleep(1); }
    }
    __syncthreads();
}
__device__ __forceinline__ void peer_unit(const Args& a, int unit, char* lds, float* outw, const XcdBarrier& gbar, unsigned* rcnt, bool rdv) {
    int tid = threadIdx.x; asm volatile("" : "+v"(tid));
    const int wid = tid >> 6, lane = tid & 63, r32 = lane & 31, hi = lane >> 5;
    unsigned char* sm = a.ws + WS_SMALL;
    const bf16_t* pq = (const bf16_t*)(a.ws + WS_Q); const bf16_t* keys = (const bf16_t*)(sm + SM_KEYS); const float* ssq2 = (const float*)(sm + SM_SSQ2);
    const bf16_t* x2b = (const bf16_t*)(a.ws + WS_XB); const unsigned char* ub = a.ws + WS_UB; const unsigned char* vb = a.ws + WS_VB;
    const float* su = (const float*)(sm + SM_SU); const float* sv = (const float*)(sm + SM_SV); const float* rsum = (const float*)(sm + SM_RSUM);
    float* sxl = (float*)(lds + SXL);
    unsigned* skey = (unsigned*)(lds + SKEY); float* sel_g = (float*)(lds + SEL_G); float* abuf = (float*)(lds + ABUFO); float* scr = (float*)(lds + SCR) + wid * 1024; float* r2 = (float*)(lds + R2);
    const size_t tok0 = (size_t)unit * 64;
    __syncthreads();
#pragma unroll
    for (int j = 0; j < 8; ++j) {
        const int tl = wid * 8 + j; float s = ssq2[(tok0 + tl) * 64 + lane]; s = wave_sum(s);
        if (lane == 0) r2[tl] = __builtin_amdgcn_rsqf(s * (1.0f / DM) + EPS);
    }
    __syncthreads();
#pragma unroll 1
    for (int task = wid; task < 16; task += NWAVES) {
        const int tg = task & 1, hh = task >> 1, tl = 32 * tg + r32;
        const float rs = r2[tl];
        const bf16_t* qrow = pq + (tok0 + tl) * PQN + hh * PQD + 8 * hi;
        float t1[16], t2[16];
        side_topk(qrow, keys + (size_t)(0 * PH + hh) * PNK * 128, rs, r32, hi, t1);
        side_topk(qrow + 128, keys + (size_t)(1 * PH + hh) * PNK * 128, rs, r32, hi, t2);
        if (hi == 0) {
#pragma unroll
            for (int j = 0; j < 16; ++j) { scr[j * 32 + r32] = t1[j]; scr[(16 + j) * 32 + r32] = t2[j]; }
        }
        float c[16];
        {
            constexpr int NC = 50;
#pragma unroll
            for (int blk = 0; blk < 4; ++blk) {
                float cb[16];
#pragma unroll
                for (int q = 0; q < 16; ++q) {
                    const int idx = 16 * blk + q;
                    int cnt2 = 0, fa = -1, fb = -1;
#pragma unroll
                    for (int ia = 0; ia < 16; ++ia)
#pragma unroll
                        for (int ib = 0; ib < 16; ++ib)
                            if ((ia + 1) * (ib + 1) <= 16) { if (cnt2 == idx) { fa = ia; fb = ib; } ++cnt2; }
                    cb[q] = (idx < NC) ? __uint_as_float((__float_as_uint(t1[fa < 0 ? 0 : fa] + t2[fb < 0 ? 0 : fb]) & ~255u) | (unsigned)((fa < 0 ? 0 : fa) * 16 + (fb < 0 ? 0 : fb))) : NEG;
                }
                sort16(cb);
                if (blk == 0) {
#pragma unroll
                    for (int i = 0; i < 16; ++i) c[i] = cb[i];
                } else merge16(c, cb);
            }
        }
        asm volatile("s_waitcnt lgkmcnt(0)" ::: "memory");
        float ev[8]; int ee[8]; float esum = 0.f;
        unsigned hmsk = hi ? 0xffffffffu : 0u; asm volatile("" : "+v"(hmsk));
        const float cmax = __uint_as_float(__float_as_uint(c[0]) & ~255u);
#pragma unroll
        for (int k = 0; k < 8; ++k) {
            const unsigned code = ((__float_as_uint(c[8 + k]) & hmsk) | (__float_as_uint(c[k]) & ~hmsk)) & 255u;
            const unsigned p1 = __float_as_uint(scr[(code >> 4) * 32 + r32]), p2 = __float_as_uint(scr[(16 + (code & 15u)) * 32 + r32]);
            const float v = __uint_as_float(p1 & ~127u) + __uint_as_float(p2 & ~127u);
            ee[k] = (int)((p1 & 127u) * PNK + (p2 & 127u));
            ev[k] = __builtin_amdgcn_exp2f((v - cmax) * LOG2E); esum += ev[k];
        }
        esum += xshfl<32>(esum);
        const float inv = __builtin_amdgcn_rcpf(esum);
#pragma unroll
        for (int k = 0; k < 8; ++k) { const int kk = hh * 16 + 8 * hi + k; skey[tl * 128 + kk] = ((unsigned)ee[k] << 7) | (unsigned)kk; sel_g[tl * 128 + kk] = ev[k] * inv; }
    }
    __syncthreads();
#pragma unroll 1
    for (int tl = wid; tl < 64; tl += NWAVES) {
        unsigned k0 = skey[tl * 128 + lane], k1 = skey[tl * 128 + 64 + lane];
#define BSTAGE(K, J) do { const unsigned o0 = xshfl_u<(J)>(k0), o1 = xshfl_u<(J)>(k1); \
        const bool up0 = ((lane & (K)) == 0), up1 = (((64 + lane) & (K)) == 0), lowl = ((lane & (J)) == 0); \
        k0 = (lowl == up0) ? (k0 < o0 ? k0 : o0) : (k0 > o0 ? k0 : o0); k1 = (lowl == up1) ? (k1 < o1 ? k1 : o1) : (k1 > o1 ? k1 : o1); } while (0)
        BSTAGE(2, 1);
        BSTAGE(4, 2); BSTAGE(4, 1);
        BSTAGE(8, 4); BSTAGE(8, 2); BSTAGE(8, 1);
        BSTAGE(16, 8); BSTAGE(16, 4); BSTAGE(16, 2); BSTAGE(16, 1);
        BSTAGE(32, 16); BSTAGE(32, 8); BSTAGE(32, 4); BSTAGE(32, 2); BSTAGE(32, 1);
        BSTAGE(64, 32); BSTAGE(64, 16); BSTAGE(64, 8); BSTAGE(64, 4); BSTAGE(64, 2); BSTAGE(64, 1);
        { const unsigned lo = k0 < k1 ? k0 : k1, hi2 = k0 < k1 ? k1 : k0; k0 = lo; k1 = hi2; }
        BSTAGE(128, 32); BSTAGE(128, 16); BSTAGE(128, 8); BSTAGE(128, 4); BSTAGE(128, 2); BSTAGE(128, 1);
#undef BSTAGE
        skey[tl * 128 + lane] = k0; skey[tl * 128 + 64 + lane] = k1;
    }
    asm volatile("s_waitcnt lgkmcnt(0)" ::: "memory");
#define KEY_AT(K0, K1, q) ((q) < 64 ? (unsigned)__builtin_amdgcn_readlane((int)(K0), (q)) : (unsigned)__builtin_amdgcn_readlane((int)(K1), (q) - 64))
#define WCOUNT(K0, K1, w) (__builtin_popcountll(__ballot((int)((K0) >> WSHIFT) == (w))) + __builtin_popcountll(__ballot((int)((K1) >> WSHIFT) == (w))))
#ifndef PEER_DUP_U
#define PEER_DUP_U 1
#endif
#pragma unroll 1
    for (int hf = 0; hf < 2 * PEER_DUP_U; ++hf) {
        int tidu = threadIdx.x; asm volatile("" : "+v"(tidu));
        const int lane = tidu & 63, wid = tidu >> 6, hv = hf & 1;
        if (hv == 0) {
#pragma unroll
            for (int g = 0; g < 8; ++g) { abuf[(wid + 8 * g) * 128 + lane] = 0.f; abuf[(wid + 8 * g) * 128 + 64 + lane] = 0.f; }
        }
        unsigned xh[8][4], xl[8][4];
#pragma unroll
        for (int g = 0; g < 8; ++g) {
            const int tl = wid + 8 * g;
            const bf16_t* xr = x2b + (tok0 + tl) * DM + lane * 4;
            float mx = 0.f;
#pragma unroll
            for (int i = 0; i < 16; ++i) { const uint2 t2 = *reinterpret_cast<const uint2*>(xr + 256 * i);
                mx = fmaxf(mx, fmaxf(fmaxf(fabsf(bf_lo(t2.x)), fabsf(bf_hi(t2.x))), fmaxf(fabsf(bf_lo(t2.y)), fabsf(bf_hi(t2.y))))); }
            mx = wave_max(mx);
            mx = fmaxf(mx, 1e-30f);
            const float inv = 127.0f / mx;
            if (lane == 0) sxl[tl] = mx * (1.0f / 127.0f);
            asm volatile("" ::: "memory");
            const bf16_t* xq = xr + 2048 * hv;
#pragma unroll
            for (int d = 0; d < 4; ++d) {
                unsigned wh = 0, wl = 0;
#pragma unroll
                for (int hh2 = 0; hh2 < 2; ++hh2) {
                    const uint2 t2 = *reinterpret_cast<const uint2*>(xq + 256 * (2 * d + hh2));
                    const float xv[4] = {bf_lo(t2.x), bf_hi(t2.x), bf_lo(t2.y), bf_hi(t2.y)};
#pragma unroll
                    for (int c = 0; c < 4; ++c) {
                        const int j = 4 * hh2 + c;
                        const unsigned u8 = (unsigned)((int)rintf(xv[c] * inv) + 128);
                        wh |= (((u8 >> 4) ^ 8u) & 15u) << (4 * j); wl |= ((u8 & 15u) ^ 8u) << (4 * j);
                    }
                }
                xh[g][d] = wh; xl[g][d] = wl;
            }
            asm volatile("" ::: "memory"); __builtin_amdgcn_sched_barrier(0);
        }
        u32x4 rr[16];
#define U_LOAD(J, G2, C2) do { const int tl_ = wid + 8 * (G2); \
            const unsigned key_ = (unsigned)__builtin_amdgcn_readfirstlane((int)skey[tl_ * 128 + 16 * (C2) + (J)]); \
            const unsigned char* up_ = ub + (size_t)(key_ >> 7) * V4ROW + lane * 16 + hv * 1024; \
            rr[J] = *reinterpret_cast<const u32x4*>(up_); } while (0)
#pragma unroll
        for (int j = 0; j < 16; ++j) U_LOAD(j, 0, 0);
#pragma unroll 1
        for (int c = 0; c < 8; ++c) {
            if (rdv && hf < 2 && (c & 1) == 0) xcc_rendezvous(gbar, rcnt + hf * 4 + (c >> 1));
            const int cn = c + 1 < 8 ? c + 1 : 7;
#pragma unroll
            for (int g = 0; g < 8; ++g) {
                const int tl = wid + 8 * g;
#pragma unroll
                for (int jj = 0; jj < 2; ++jj) {
                    float sr[8];
#pragma unroll
                    for (int j = 0; j < 8; ++j) {
                        int ah = 0, al = 0;
#pragma unroll
                        for (int d = 0; d < 4; ++d) { const int wv = (int)rr[8 * jj + j][d];
                            ah = __builtin_amdgcn_sdot8(wv, (int)xh[g][d], ah, false); al = __builtin_amdgcn_sdot8(wv, (int)xl[g][d], al, false); }
                        sr[j] = (float)(16 * ah + al);
                        if (g + 1 < 8) U_LOAD(8 * jj + j, (g + 1 < 8 ? g + 1 : 0), c); else U_LOAD(8 * jj + j, 0, cn);
                        __builtin_amdgcn_sched_barrier(0);
                    }
                    {
                        const bool b0 = lane & 1, b1 = lane & 2, b2 = lane & 4;
                        float t4[4], t2[2], t1;
#pragma unroll
                        for (int j = 0; j < 4; ++j) { const float keep = b0 ? sr[2 * j + 1] : sr[2 * j], give = b0 ? sr[2 * j] : sr[2 * j + 1]; t4[j] = keep + xshfl<1>(give); }
#pragma unroll
                        for (int j = 0; j < 2; ++j) { const float keep = b1 ? t4[2 * j + 1] : t4[2 * j], give = b1 ? t4[2 * j] : t4[2 * j + 1]; t2[j] = keep + xshfl<2>(give); }
                        { const float keep = b2 ? t2[1] : t2[0], give = b2 ? t2[0] : t2[1]; t1 = keep + xshfl<4>(give); }
                        t1 += xshfl<8>(t1); t1 += xshfl<16>(t1); t1 += xshfl<32>(t1);
                        if (lane < 8) abuf[tl * 128 + 16 * c + 8 * jj + lane] += t1;
                    }
                }
            }
        }
#undef U_LOAD
    }
    asm volatile("s_waitcnt lgkmcnt(0)" ::: "memory");
#pragma unroll 1
    for (int tl = wid; tl < 64; tl += NWAVES) {
        const float rs = r2[tl];
#pragma unroll
        for (int r = 0; r < 2; ++r) {
            const unsigned key = skey[tl * 128 + 64 * r + lane]; const int e = (int)(key >> 7), kk = (int)(key & 127u);
            const float av = (abuf[tl * 128 + 64 * r + lane] + 8.0f * rsum[e]) * (rs * sxl[tl]) * su[e];
            abuf[tl * 128 + 64 * r + lane] = sel_g[tl * 128 + kk] * gelu_tanh(av) * sv[e];
        }
    }
    asm volatile("s_waitcnt lgkmcnt(0)" ::: "memory");
    typedef _Float16 h2_t __attribute__((ext_vector_type(2)));
#pragma unroll 1
    for (int rnd = 0; rnd < 2; ++rnd) {
        int tidv = threadIdx.x; asm volatile("" : "+v"(tidv));
        const int lane = tidv & 63, wid = tidv >> 6;
        h2_t y[4][32];
#pragma unroll
        for (int g = 0; g < 4; ++g) {
            const int tl = wid + 8 * (4 * rnd + g);
#pragma unroll
            for (int i = 0; i < 32; ++i) y[g][i] = (h2_t){(_Float16)0.f, (_Float16)0.f};
        }
        u32x4 rr[8][2];
#define V_LOAD(J, G2, C2) do { const int tl_ = wid + 8 * (4 * rnd + (G2)); \
            const unsigned key_ = (unsigned)__builtin_amdgcn_readfirstlane((int)skey[tl_ * 128 + 8 * (C2) + (J)]); \
            const unsigned char* vp_ = vb + (size_t)(key_ >> 7) * V4ROW + lane * 16; \
            rr[J][0] = *reinterpret_cast<const u32x4*>(vp_); rr[J][1] = *reinterpret_cast<const u32x4*>(vp_ + 1024); } while (0)
#pragma unroll
        for (int j = 0; j < 8; ++j) V_LOAD(j, 0, 0);
#pragma unroll 1
        for (int c = 0; c < 16; ++c) {
            const int cn = c + 1 < 16 ? c + 1 : 15;
#pragma unroll
            for (int g = 0; g < 4; ++g) {
#pragma unroll
                for (int j = 0; j < 8; ++j) {
                    const _Float16 wh = (_Float16)abuf[(wid + 8 * (4 * rnd + g)) * 128 + 8 * c + j]; const h2_t w2 = {wh, wh};
#pragma unroll
                    for (int d = 0; d < 8; ++d) {
                        const int wv = (int)rr[j][d >> 2][d & 3];
                        y[g][4 * d + 0] = __builtin_elementwise_fma(__builtin_bit_cast(h2_t, __builtin_amdgcn_cvt_scalef32_pk_f16_fp4(wv, 1.0f, 0)), w2, y[g][4 * d + 0]);
                        y[g][4 * d + 1] = __builtin_elementwise_fma(__builtin_bit_cast(h2_t, __builtin_amdgcn_cvt_scalef32_pk_f16_fp4(wv, 1.0f, 1)), w2, y[g][4 * d + 1]);
                        y[g][4 * d + 2] = __builtin_elementwise_fma(__builtin_bit_cast(h2_t, __builtin_amdgcn_cvt_scalef32_pk_f16_fp4(wv, 1.0f, 2)), w2, y[g][4 * d + 2]);
                        y[g][4 * d + 3] = __builtin_elementwise_fma(__builtin_bit_cast(h2_t, __builtin_amdgcn_cvt_scalef32_pk_f16_fp4(wv, 1.0f, 3)), w2, y[g][4 * d + 3]);
                    }
                    if (g + 1 < 4) V_LOAD(j, (g + 1 < 4 ? g + 1 : 0), c); else V_LOAD(j, 0, cn);
                    __builtin_amdgcn_sched_barrier(0);
                }
            }
        }
#undef V_LOAD
#pragma unroll
        for (int g = 0; g < 4; ++g) {
            const size_t tok = tok0 + wid + 8 * (4 * rnd + g);
            const bf16_t* ip = x2b + tok * DM + lane * 4; float* op = outw + tok * DM + lane * 4;
#pragma unroll
            for (int i = 0; i < 16; ++i) {
                const uint2 xw = *reinterpret_cast<const uint2*>(ip + 256 * i);
                f32x4 p;
                p[0] = bf_lo(xw.x) + (float)y[g][2 * i].x; p[1] = bf_hi(xw.x) + (float)y[g][2 * i].y; p[2] = bf_lo(xw.y) + (float)y[g][2 * i + 1].x; p[3] = bf_hi(xw.y) + (float)y[g][2 * i + 1].y;
                __builtin_nontemporal_store(p, reinterpret_cast<f32x4*>(op + 256 * i));
            }
        }
    }
#undef KEY_AT
#undef WCOUNT
}
}

constexpr int N_PHASES = 7;
#ifndef MK_N_LAUNCHES
#define MK_N_LAUNCHES 1
#endif
__global__ void __launch_bounds__(NTHREADS, 2) mk_fwd(Args args) {
    extern __shared__ __attribute__((aligned(16))) unsigned char lds[];
    const int tid = threadIdx.x;
    unsigned char* ws = args.ws; unsigned char* sm = ws + WS_SMALL;
    unsigned* ctl = (unsigned*)(ws + WS_CTL);
    volatile LAS unsigned* misc = (volatile LAS unsigned*)((LAS unsigned char*)lds + LDS_MISC);
    if (tid < 16) misc[tid] = 0u;
    __syncthreads();
    const int lo = args.ph_lo, hi = args.ph_hi;
    const bool multi = (hi - lo) > 1;
    XcdBarrier bar; bar.bar = ctl + CW_BAR; bar.x = 0; bar.st = misc;
    if (multi) bar = xcd_barrier_post(ctl + CW_BAR, misc);
#ifndef PH_MASK
#define PH_MASK 0x7f
#endif
#define IN(k) (((PH_MASK >> (k)) & 1) && lo <= (k) && (k) < hi)
#define SEAM(k) do { if (IN(k) && IN((k) + 1)) xcd_barrier(bar); } while (0)
#ifndef DUP_MASK
#define DUP_MASK 0
#endif
#define DUP(k) (((DUP_MASK >> (k)) & 1) != 0)

#ifndef TABLES_LATE
#define TABLES_LATE 0
#endif

    if (IN(0)) { p0_prologue(args, (char*)lds);
#if !TABLES_LATE && !TABLES_IN_P2
        p0_tables(args);
#endif
 if (DUP(0)) { xcd_barrier(bar); p0_prologue(args, (char*)lds); p0_tables(args); } SEAM(0); }

    if (IN(1)) {
        pg8::Gemm g{(const bf16_t*)(ws + WS_XB), (const bf16_t*)(ws + WS_WIN), TOK, NIN, DM};
        pg8::StaticOrder S; S.init(TOK, NIN, (int)gridDim.x, (int)blockIdx.x);
        pg8::EpiProj E{(bf16_t*)(ws + WS_Q), (size_t)(WS_K - WS_Q) / 2, (const float*)(sm + SM_RSTD1), args.in[3], args.in[4], (LAS float*)((LAS unsigned char*)lds + LDS_XCH)};
        pg8::gemm_phase<pg8::EpiProj, pg8::StaticOrder, false>((LAS unsigned char*)lds, g, S, E, nullptr);
        if (DUP(1)) { xcd_barrier(bar); pg8::gemm_phase<pg8::EpiProj, pg8::StaticOrder, false>((LAS unsigned char*)lds, g, S, E, nullptr); }
        SEAM(1);
    }

    if (IN(2)) {
#ifndef DUP_REC
#define DUP_REC 0
#endif
#ifndef DUP_ATT
#define DUP_ATT 0
#endif
#pragma unroll 1
        for (int rep = 0; rep < 1 + DUP_REC; ++rep) {
            if (rep) xcd_barrier(bar);
            for (;;) {
                __syncthreads();
                if (tid == 0) misc[4] = __hip_atomic_fetch_add(ctl + CW_QUEUE + 256 * rep, 1u, RLX_AGENT);
                __syncthreads();
                const int item = (int)misc[4];
                if (item >= 64) break;
                rec::rec_chain((const bf16_t*)(ws + WS_XR), (const bf16_t*)(ws + WS_GY), args.in[6], args.in[7], (const bf16_t*)(sm + SM_WGT), args.in[9], args.in[11], args.in[12],
                               (bf16_t*)(ws + WS_MIX), (float*)(sm + SM_RSSQ), item >> 4, item & 15, (char*)lds);
            }
        }
#pragma unroll 1
        for (int rep = 0; rep < 1 + DUP_ATT; ++rep) {
            if (rep) xcd_barrier(bar);
#if TABLES_IN_P2
            {
                constexpr int NAUX = TBL_ITEMS + TR_ITEMS, NTOT = 1024 + NAUX;
                static_assert(NAUX * 27 == NTOT * 11, "interleave ratio");
                unsigned nxt = 0;
                if (tid == 0) nxt = __hip_atomic_fetch_add(ctl + CW_QUEUE + 64 + 256 * rep, 1u, RLX_AGENT);
                for (;;) {
                    __syncthreads();
                    if (tid == 0) misc[4] = nxt;
                    __syncthreads();
                    const int qi = (int)misc[4];
                    if (qi >= NTOT) break;
                    if (tid == 0) nxt = __hip_atomic_fetch_add(ctl + CW_QUEUE + 64 + 256 * rep, 1u, RLX_AGENT);
                    const int ab = qi * 11 / 27, aa = (qi + 1) * 11 / 27;
                    if (aa > ab) {
                        if (ab < TBL_ITEMS) p0_tables_item(args, ab);
                        else transpose_seq<false>(args, (char*)lds, (ab - TBL_ITEMS) * TR_ITEM_TILES, 1, (ab - TBL_ITEMS + 1) * TR_ITEM_TILES);
                        continue;
                    }
                    const int u = qi - ab;
                    const int g = 15 - (u >> 6), bh = u & 63;
                    att::attn_unit((const bf16_t*)(ws + WS_Q), (const bf16_t*)(ws + WS_K), (const bf16_t*)(ws + WS_V), args.in[5], (bf16_t*)(ws + WS_MIX), (float*)(sm + SM_ASSQ), bh >> 4, bh & 15, g, (char*)lds);
                }
            }
#else
            for (;;) {
                __syncthreads();
                if (tid == 0) misc[4] = __hip_atomic_fetch_add(ctl + CW_QUEUE + 64 + 256 * rep, 1u, RLX_AGENT);
                __syncthreads();
                const int u = (int)misc[4];
                if (u >= 1024) break;
                const int g = 15 - (u >> 6), bh = u & 63;
                att::attn_unit((const bf16_t*)(ws + WS_Q), (const bf16_t*)(ws + WS_K), (const bf16_t*)(ws + WS_V), args.in[5], (bf16_t*)(ws + WS_MIX), (float*)(sm + SM_ASSQ), bh >> 4, bh & 15, g, (char*)lds);
            }
#endif
        }
        SEAM(2);
    }


    if (IN(4)) {
        pg8::Gemm g{(const bf16_t*)(ws + WS_MIX), (const bf16_t*)(ws + WS_WOUT), TOK, DM, DM / 2};
        pg8::StaticOrder S; S.init(TOK, DM, (int)gridDim.x, (int)blockIdx.x);
        LAS float* rs = (LAS float*)((LAS unsigned char*)lds + LDS_XCH);
        {
            const float* assq = (const float*)(sm + SM_ASSQ); const float* rssq = (const float*)(sm + SM_RSSQ);
            if (tid < 256) {
                for (int i = 0; i < 4; ++i) { pg8::Unit u; if (!S.next(i, u)) break;
                    const size_t row = (size_t)u.pm * 256 + tid; float sa = 0.f, sr = 0.f;
#pragma unroll
                    for (int j = 0; j < 4; ++j) { const f32x4 pa = *reinterpret_cast<const f32x4*>(assq + row * 16 + 4 * j), pr = *reinterpret_cast<const f32x4*>(rssq + row * 16 + 4 * j);
                        sa += (pa[0] + pa[1]) + (pa[2] + pa[3]); sr += (pr[0] + pr[1]) + (pr[2] + pr[3]); }
                    const float ra = __builtin_amdgcn_rsqf(sa * (1.0f / DATT) + EPS), rr = __builtin_amdgcn_rsqf(sr * (1.0f / DREC) + EPS);
                    const float ra8 = ra * (1.0f / (W8S * MIX_SA)), rr8 = rr * (1.0f / (W8S * MIX_SR));
                    rs[i * 512 + tid] = ra8 / rr8; rs[i * 512 + 256 + tid] = rr8; }
            }
            __syncthreads();
        }
        pg8::EpiOut E{args.in[0], args.out, (bf16_t*)(ws + WS_XB), (float*)(sm + SM_SSQ2), rs, 0};
        pg8::gemm_phase<pg8::EpiOut, pg8::StaticOrder, false, true>((LAS unsigned char*)lds, g, S, E, nullptr);
        if (DUP(4)) { xcd_barrier(bar); pg8::gemm_phase<pg8::EpiOut, pg8::StaticOrder, false, true>((LAS unsigned char*)lds, g, S, E, nullptr); }
        SEAM(4);
    }

    if (IN(5)) {
        pg8::Gemm g{(const bf16_t*)(ws + WS_XB), (const bf16_t*)(ws + WS_WPQ), TOK, PQN, DM};
        pg8::StaticOrder S; S.init(TOK, PQN, (int)gridDim.x, (int)blockIdx.x);
        pg8::EpiPq E{(bf16_t*)(ws + WS_Q)};
        pg8::gemm_phase<pg8::EpiPq, pg8::StaticOrder, false>((LAS unsigned char*)lds, g, S, E, nullptr);
        if (DUP(5)) { xcd_barrier(bar); pg8::gemm_phase<pg8::EpiPq, pg8::StaticOrder, false>((LAS unsigned char*)lds, g, S, E, nullptr); }
        SEAM(5);
    }

    if (IN(6)) {
#if TABLES_LATE
        p0_tables(args); if (multi) xcd_barrier(bar);
#endif
        const bool one_each = multi && (int)gridDim.x == TOK / 64;
        for (int u = blockIdx.x; u < TOK / 64; u += gridDim.x) peer::peer_unit(args, u, (char*)lds, args.out, bar, ctl + CW_XCNT, one_each);
        if (DUP(6)) { xcd_barrier(bar); for (int u = blockIdx.x; u < TOK / 64; u += gridDim.x) peer::peer_unit(args, u, (char*)lds, (float*)(ws + WS_V), bar, ctl + CW_XCNT, false); }
    }
#undef IN
#undef SEAM
}

extern "C" void kernel_launch(void* const* d_in, const int* in_sizes, int n_in, void* d_out, int out_size, void* d_ws, size_t ws_size, hipStream_t stream) {
    static int grid = 0;
    if (grid == 0) {
        if (n_in != 22 || in_sizes[0] != TOK * DM || out_size != TOK * DM || ws_size < WS_END) {
            fprintf(stderr, "kernel_launch: built for 22 inputs, x/out of %d floats, >= %zu bytes of workspace; got n_in %d, in0 %d, out %d, ws %zu; nothing launched\n", TOK * DM, (size_t)WS_END, n_in, n_in > 0 ? in_sizes[0] : -1, out_size, ws_size);
            grid = -1; return; }
        int dev = 0, cus = 0, per_cu = 0;
        if (hipGetDevice(&dev) != hipSuccess || hipDeviceGetAttribute(&cus, hipDeviceAttributeMultiprocessorCount, dev) != hipSuccess) { fprintf(stderr, "kernel_launch: device query failed\n"); grid = -1; return; }
        if (hipFuncSetAttribute((const void*)mk_fwd, hipFuncAttributeMaxDynamicSharedMemorySize, LDS_BYTES) != hipSuccess) { fprintf(stderr, "kernel_launch: hipFuncSetAttribute failed\n"); grid = -1; return; }
        if (hipOccupancyMaxActiveBlocksPerMultiprocessor(&per_cu, (const void*)mk_fwd, NTHREADS, LDS_BYTES) != hipSuccess || per_cu < 1)
            fprintf(stderr, "kernel_launch: note: occupancy query reports %d workgroups per CU\n", per_cu);
        (void)hipGetLastError();
        grid = cus;
    }
    if (grid < 0) return;
    if (hipMemsetAsync((char*)d_ws + WS_CTL, 0, CTL_BYTES, stream) != hipSuccess) { fprintf(stderr, "kernel_launch: memset failed\n"); return; }
    Args a{};
    for (int i = 0; i < 22; ++i) a.in[i] = (const float*)d_in[i];
    a.out = (float*)d_out; a.ws = (unsigned char*)d_ws;
#if MK_N_LAUNCHES == 1
    a.ph_lo = 0; a.ph_hi = N_PHASES;
    hipLaunchKernelGGL(mk_fwd, dim3(grid), dim3(NTHREADS), LDS_BYTES, stream, a);
#else
    for (int p = 0; p < N_PHASES; ++p) { a.ph_lo = p; a.ph_hi = p + 1; hipLaunchKernelGGL(mk_fwd, dim3(grid), dim3(NTHREADS), LDS_BYTES, stream, a); }
#endif
    const hipError_t le = hipPeekAtLastError();
    if (le != hipSuccess) fprintf(stderr, "kernel_launch: launch failed: %s\n", hipGetErrorName(le));
}
```
